# Optimizing an MI355X kernel written in HIP

```python
import math
import jax, jax.numpy as jnp
from jax import lax
import numpy as np

D_MODEL = 2048
BATCH = 4
SEQ = 8192
DEPTH = 1

MIX_WIDTH = D_MODEL
HEAD_DIM = 128
A_WIDTH = MIX_WIDTH // 2
A_HEADS = A_WIDTH // HEAD_DIM
A_KV_HEADS = 2
WINDOW = 128
BLOCK = 128
B_WIDTH = MIX_WIDTH - A_WIDTH
B_QK_DIM = 64
B_V_DIM = 2 * B_QK_DIM
B_HEADS = B_WIDTH // B_V_DIM
N_ATTN_HEADS = A_HEADS + B_HEADS
D_FF = -(-8 * D_MODEL // (3 * 256)) * 256
N_MOD = 6
EPS = 1e-6
NEG_INF = -1e30

A_Q_COLS = A_HEADS * HEAD_DIM
A_KV_COLS = A_KV_HEADS * HEAD_DIM
B_Q_COLS = B_HEADS * 2 * B_QK_DIM
B_K_COLS = B_HEADS * 2 * B_QK_DIM
B_V_COLS = B_HEADS * B_V_DIM
IN_COLS = A_Q_COLS + 2 * A_KV_COLS + B_Q_COLS + B_K_COLS + B_V_COLS

kernel_name = "hymba_style_window_gqa_diff_attn_swiglu_block"


def rms_norm(x, gain):
    xf = x.astype(jnp.float32)
    y = xf * lax.rsqrt(jnp.mean(xf * xf, axis=-1, keepdims=True) + EPS)
    return (y * gain.astype(jnp.float32)).astype(x.dtype)


def alibi_slopes(n):
    return 2.0 ** (-8.0 * jnp.arange(1, n + 1, dtype=jnp.float32) / n)


def lambda_init_fn(layer_idx):
    return 0.8 - 0.6 * math.exp(-0.3 * layer_idx)


def windowed_gqa(q, k, v, sink, slopes):
    b_, s_, _, dh = q.shape
    nb = s_ // BLOCK
    g_ = A_HEADS // A_KV_HEADS
    qb = q.reshape(b_, nb, BLOCK, A_KV_HEADS, g_, dh)
    pad = ((0, 0), (BLOCK, BLOCK), (0, 0), (0, 0))
    kp = jnp.pad(k, pad).reshape(b_, nb + 2, BLOCK, A_KV_HEADS, dh)
    vp = jnp.pad(v, pad).reshape(b_, nb + 2, BLOCK, A_KV_HEADS, dh)
    kb = jnp.concatenate([kp[:, :-2], kp[:, 1:-1], kp[:, 2:]], axis=2)
    vb = jnp.concatenate([vp[:, :-2], vp[:, 1:-1], vp[:, 2:]], axis=2)
    scores = jnp.einsum('bnqhgd,bnshd->bnhgqs', qb, kb).astype(jnp.float32) * (dh ** -0.5)
    qpos = jnp.arange(BLOCK)[:, None] + BLOCK
    kpos = jnp.arange(3 * BLOCK)[None, :]
    dist = jnp.abs(qpos - kpos)
    kabs = jnp.arange(nb)[:, None] * BLOCK - BLOCK + kpos
    valid = (dist <= WINDOW)[None] & ((kabs >= 0) & (kabs < s_))[:, None, :]
    bias = -slopes.reshape(A_KV_HEADS, g_)[:, :, None, None] * dist.astype(jnp.float32)
    scores = jnp.where(valid[None, :, None, None], scores + bias[None, None], NEG_INF)
    sink_b = sink.astype(jnp.float32).reshape(1, 1, A_KV_HEADS, g_, 1, 1)
    m = jnp.maximum(jnp.max(scores, axis=-1, keepdims=True), sink_b)
    p = jnp.exp(scores - m)
    probs = p / (jnp.sum(p, axis=-1, keepdims=True) + jnp.exp(sink_b - m))
    out = jnp.einsum('bnhgqs,bnshd->bnqhgd', probs.astype(v.dtype), vb)
    return out.reshape(b_, s_, A_HEADS * dh)


def diff_attention(q, k, v, lam, slopes):
    b_, s_, h_, _, dq = q.shape
    nb = s_ // BLOCK
    qblocks = jnp.moveaxis(q.reshape(b_, nb, BLOCK, h_, 2, dq), 1, 0)
    kpos = jnp.arange(s_)

    def one_block(args):
        qb, i = args
        sc = jnp.einsum('bqhcd,bshcd->bhcqs', qb, k).astype(jnp.float32) * (dq ** -0.5)
        qpos = i * BLOCK + jnp.arange(BLOCK)
        dist = jnp.abs(qpos[:, None] - kpos[None, :]).astype(jnp.float32)
        sc = sc - slopes[None, :, None, None, None] * dist[None, None, None]
        p = jax.nn.softmax(sc, axis=-1)
        w = p[:, :, 0] - lam * p[:, :, 1]
        return jnp.einsum('bhqs,bshd->bqhd', w.astype(v.dtype), v)

    out = lax.map(one_block, (qblocks, jnp.arange(nb)))
    return jnp.moveaxis(out, 0, 1).reshape(b_, s_, h_, v.shape[-1])


def setup_inputs(seed: int = 0) -> dict:
    key = jax.random.key(seed)
    ks = jax.random.split(key, 20)
    f32 = jnp.float32
    nrm = lambda k, shape, scale: jax.random.normal(k, shape, f32) * scale
    gain = lambda k, shape: 1.0 + 0.02 * jax.random.normal(k, shape, f32)
    return {
        "x": jax.random.normal(ks[0], (BATCH, SEQ, D_MODEL), f32),
        "c": jax.random.normal(ks[1], (BATCH, D_MODEL), f32),
        "w_ada": nrm(ks[2], (DEPTH, D_MODEL, N_MOD * D_MODEL), 0.5 * D_MODEL ** -0.5),
        "b_ada": nrm(ks[3], (DEPTH, N_MOD * D_MODEL), 0.01),
        "norm1_gain": gain(ks[4], (DEPTH, D_MODEL)),
        "w_in": nrm(ks[5], (DEPTH, D_MODEL, IN_COLS), D_MODEL ** -0.5),
        "a_sink": nrm(ks[6], (DEPTH, A_HEADS), 0.5),
        "a_out_gain": gain(ks[7], (DEPTH, A_WIDTH)),
        "diff_lq1": nrm(ks[8], (DEPTH, B_QK_DIM), 0.1),
        "diff_lk1": nrm(ks[9], (DEPTH, B_QK_DIM), 0.1),
        "diff_lq2": nrm(ks[10], (DEPTH, B_QK_DIM), 0.1),
        "diff_lk2": nrm(ks[11], (DEPTH, B_QK_DIM), 0.1),
        "diff_subln_gain": gain(ks[12], (DEPTH, B_V_DIM)),
        "w_o": nrm(ks[13], (DEPTH, MIX_WIDTH, D_MODEL), MIX_WIDTH ** -0.5),
        "norm2_gain": gain(ks[14], (DEPTH, D_MODEL)),
        "w_gate": nrm(ks[15], (DEPTH, D_MODEL, D_FF), D_MODEL ** -0.5),
        "w_up": nrm(ks[16], (DEPTH, D_MODEL, D_FF), D_MODEL ** -0.5),
        "w_down": nrm(ks[17], (DEPTH, D_FF, D_MODEL), D_FF ** -0.5),
        "final_gain": gain(ks[18], (D_MODEL,)),
    }


def reference(x, c, w_ada, b_ada, norm1_gain, w_in, a_sink, a_out_gain,
              diff_lq1, diff_lk1, diff_lq2, diff_lk2, diff_subln_gain, w_o,
              norm2_gain, w_gate, w_up, w_down, final_gain):
    b_, s_, _ = x.shape
    slopes = alibi_slopes(N_ATTN_HEADS)
    slopes_a, slopes_b = slopes[:A_HEADS], slopes[A_HEADS:]
    o1 = A_Q_COLS
    o2 = o1 + A_KV_COLS
    o3 = o2 + A_KV_COLS
    o4 = o3 + B_Q_COLS
    o5 = o4 + B_K_COLS
    for l in range(DEPTH):
        mod = jnp.einsum('bd,de->be', jax.nn.silu(c), w_ada[l]) + b_ada[l]
        sh1, sc1, g1, sh2, sc2, g2 = jnp.split(mod[:, None, :], N_MOD, axis=-1)

        h = rms_norm(x, norm1_gain[l]) * (1.0 + sc1) + sh1
        proj = jnp.einsum('bsd,de->bse', h, w_in[l])
        qa = proj[..., :o1].reshape(b_, s_, A_HEADS, HEAD_DIM)
        ka = proj[..., o1:o2].reshape(b_, s_, A_KV_HEADS, HEAD_DIM)
        va = proj[..., o2:o3].reshape(b_, s_, A_KV_HEADS, HEAD_DIM)
        qd = proj[..., o3:o4].reshape(b_, s_, B_HEADS, 2, B_QK_DIM)
        kd = proj[..., o4:o5].reshape(b_, s_, B_HEADS, 2, B_QK_DIM)
        vd = proj[..., o5:].reshape(b_, s_, B_HEADS, B_V_DIM)

        out_a = rms_norm(windowed_gqa(qa, ka, va, a_sink[l], slopes_a), a_out_gain[l])

        lam_init = lambda_init_fn(l)
        lam = (jnp.exp(jnp.sum(diff_lq1[l].astype(jnp.float32) * diff_lk1[l].astype(jnp.float32)))
               - jnp.exp(jnp.sum(diff_lq2[l].astype(jnp.float32) * diff_lk2[l].astype(jnp.float32)))
               + lam_init)
        od = diff_attention(qd, kd, vd, lam, slopes_b)
        out_b = (rms_norm(od, diff_subln_gain[l]) * (1.0 - lam_init)).reshape(b_, s_, B_WIDTH)

        mix = jnp.einsum('bse,ed->bsd', jnp.concatenate([out_a, out_b], axis=-1), w_o[l])
        x = x + g1 * mix

        h2 = rms_norm(x, norm2_gain[l]) * (1.0 + sc2) + sh2
        ff = jax.nn.silu(jnp.einsum('bsd,df->bsf', h2, w_gate[l])) * jnp.einsum('bsd,df->bsf', h2, w_up[l])
        x = x + g2 * jnp.einsum('bsf,fd->bsd', ff, w_down[l])
    return rms_norm(x, final_gain)
```

```cpp
#include <hip/hip_runtime.h>
#include <hip/hip_cooperative_groups.h>
#include <cstdio>
#include <cstdint>
namespace cg = cooperative_groups;
namespace pg8 {
#define PG8_LAS __attribute__((address_space(3)))
typedef unsigned short bf16_t;
typedef short bf16x8 __attribute__((ext_vector_type(8)));
typedef float f32x4 __attribute__((ext_vector_type(4)));
typedef unsigned u32x4 __attribute__((ext_vector_type(4)));
constexpr int BM = 256, BK = 64, HALF = 128, HTB = HALF * BK * 2  , STAGE_BYTES = 8 * HTB, NXCD = 8, WGM = 8;

__host__ __device__ __forceinline__ int lds_byte(int r, int c) { const int st = (r >> 4) * 2 + (c >> 5), rr = r & 15, cc = c & 31, ob = rr * 64 + cc * 2; return st * 1024 + (ob ^ (((ob >> 9) & 1) << 5)); }
__host__ __device__ __forceinline__ void stage_rc(int b, int& R, int& C) { const int st = b / 1024, sb = b % 1024, swz = sb ^ (((sb >> 9) & 1) << 5); R = (st >> 1) * 16 + swz / 64; C = (st & 1) * 32 + (swz % 64) / 2; }
__host__ __device__ __forceinline__ int perm32(int rho) { const int n = rho >> 4, i = rho & 15; return 8 * (i >> 2) + 4 * n + (i & 3); }

struct Unit { int pm, pn; };
struct Gemm { const bf16_t* A; const bf16_t* Bt; int M, N, K; };

struct StaticOrder {
    int nM, nN, nwg, G, c;
    __host__ __device__ void init(int M, int N, int G_, int c_) { nM = M / BM; nN = N / BM; nwg = nM * nN; G = G_; c = c_; }
    __host__ __device__ bool next(int i, Unit& u) const {
        const long L = (long)i * G + c; if (L >= nwg) return false;
        int wgid = (int)L; { const int q = nwg / NXCD, r = nwg % NXCD, xcd = wgid % NXCD, off = wgid / NXCD; wgid = (xcd < r ? xcd * (q + 1) : r * (q + 1) + (xcd - r) * q) + off; }
        const int nig = WGM * nN, gid = wgid / nig, fm = gid * WGM, gsz = (nM - fm) < WGM ? (nM - fm) : WGM;
        u.pm = fm + ((wgid % nig) % gsz); u.pn = (wgid % nig) / gsz; return true;
    }
    __device__ __forceinline__ void a_ready(const Unit&) const {}
    __device__ __forceinline__ void done(const Unit&) const {}
};
__device__ __forceinline__ unsigned cvt_pk_bf16(float lo, float hi) { unsigned r; asm volatile("v_cvt_pk_bf16_f32 %0, %1, %2" : "=v"(r) : "v"(lo), "v"(hi)); return r; }
typedef float f32x2 __attribute__((ext_vector_type(2)));
typedef __bf16 bf16x2v __attribute__((ext_vector_type(2)));
__device__ __forceinline__ unsigned cvtpk(float lo, float hi) { f32x2 v = {lo, hi}; bf16x2v b = __builtin_convertvector(v, bf16x2v); return __builtin_bit_cast(unsigned, b); }

struct EpiStoreBf16 {
    static constexpr bool PERM = true, AFTER_DRAIN = false;
    bf16_t* O; int ldc; float scA, scB; unsigned char* kvb;
    __device__ __forceinline__ void operator()(const f32x4 (&acc)[2][2][4][2], const Unit& u, int wr, int wc, int fr, int fq) const {
        const int row0 = u.pm * BM + wr * 64 + fr, col0 = u.pn * BM + wc * 32 + 8 * fq;
        const float sc = (u.pn < 4) ? scA : ((u.pn >= 6 && u.pn < 10) ? scB : 1.0f);
        const bool kd = (u.pn >= 10 && u.pn < 14);
#pragma unroll
        for (int ai = 0; ai < 2; ++ai)
#pragma unroll
            for (int m = 0; m < 4; ++m) { const int row = row0 + ai * HALF + m * 16; bf16_t* rowp = O + (size_t)row * ldc + col0;
                const int b = row >> 13, tok = row & 8191, rr = tok & 63;
                unsigned char* kp = kvb + ((size_t)((b * 8 + 2 * (u.pn - 10)) * 128 + (tok >> 6))) * 32768 + (wc >> 1) * 8192 + rr * 128 + ((((wc & 1) * 4 + fq) ^ ((rr >> 1) & 7)) << 4);
#pragma unroll
                for (int bj = 0; bj < 2; ++bj) { const f32x4 v0 = acc[ai][bj][m][0] * sc, v1 = acc[ai][bj][m][1] * sc;
                    u32x4 w; w.x = cvtpk(v0[0], v0[1]); w.y = cvtpk(v0[2], v0[3]); w.z = cvtpk(v1[0], v1[1]); w.w = cvtpk(v1[2], v1[3]);
                    if (kd) *(u32x4*)(kp + (size_t)bj * 128 * 32768) = w; else *(u32x4*)(rowp + bj * HALF) = w; } }
    }
};
struct EpiResGate {
    static constexpr bool PERM = false, AFTER_DRAIN = false;
    const float* base; float* out; int ldc; const float* modg; const float* badag;
    __device__ __forceinline__ void operator()(const f32x4 (&acc)[2][2][4][2], const Unit& u, int wr, int wc, int fr, int fq) const {
        const int row0 = u.pm * BM + wr * 64 + fr, col0 = u.pn * BM + wc * 32 + 4 * fq, b = u.pm >> 5;
        f32x4 gv[2][2];
#pragma unroll
        for (int bj = 0; bj < 2; ++bj)
#pragma unroll
            for (int n = 0; n < 2; ++n) gv[bj][n] = *(const f32x4*)(modg + (size_t)b * 12288 + col0 + bj * HALF + n * 16) + *(const f32x4*)(badag + col0 + bj * HALF + n * 16);
#pragma unroll
        for (int ai = 0; ai < 2; ++ai)
#pragma unroll
            for (int m = 0; m < 4; ++m) { const size_t off = (size_t)(row0 + ai * HALF + m * 16) * ldc + col0;
#pragma unroll
                for (int bj = 0; bj < 2; ++bj)
#pragma unroll
                    for (int n = 0; n < 2; ++n) { const f32x4 bs = *(const f32x4*)(base + off + bj * HALF + n * 16);
                        *(f32x4*)(out + off + bj * HALF + n * 16) = bs + gv[bj][n] * acc[ai][bj][m][n]; }
                asm volatile("" ::: "memory"); }
    }
};
struct EpiSwiGLU {
    static constexpr bool PERM = true, AFTER_DRAIN = false;
    bf16_t* O; int ldc;
    static __device__ __forceinline__ float sw(float g, float up) { return g * __builtin_amdgcn_rcpf(1.0f + __builtin_amdgcn_exp2f(-1.44269504f * g)) * up; }
    __device__ __forceinline__ void operator()(const f32x4 (&acc)[2][2][4][2], const Unit& u, int wr, int wc, int fr, int fq) const {
        const int row0 = u.pm * BM + wr * 64 + fr, col0 = u.pn * HALF + wc * 32 + 8 * fq;
#pragma unroll
        for (int ai = 0; ai < 2; ++ai)
#pragma unroll
            for (int m = 0; m < 4; ++m) { bf16_t* rowp = O + (size_t)(row0 + ai * HALF + m * 16) * ldc + col0;
                const f32x4 g0 = acc[ai][0][m][0], g1 = acc[ai][0][m][1], u0 = acc[ai][1][m][0], u1 = acc[ai][1][m][1];
                u32x4 w; w.x = cvtpk(sw(g0[0], u0[0]), sw(g0[1], u0[1])); w.y = cvtpk(sw(g0[2], u0[2]), sw(g0[3], u0[3]));
                w.z = cvtpk(sw(g1[0], u1[0]), sw(g1[1], u1[1])); w.w = cvtpk(sw(g1[2], u1[2]), sw(g1[3], u1[3]));
                *(u32x4*)rowp = w; }
    }
};

template <class Epi, class Sched, bool ALIGN_EPI = false, bool SP2 = false>
__device__ __forceinline__ void gemm_phase(PG8_LAS unsigned char* lds, const Gemm g, const Sched& S, const Epi& E) {
    int tid_ = threadIdx.x; asm volatile("" : "+v"(tid_));
    const int tid = tid_, wid = __builtin_amdgcn_readfirstlane(tid >> 6), lane = tid & 63, wr = wid >> 2, wc = wid & 3, fr = lane & 15, fq = lane >> 4;
    const int K = g.K, nt = K / BK;
    unsigned voffA[2], voffB[2];
#pragma unroll
    for (int i = 0; i < 2; ++i) { int R, C; stage_rc(tid * 16 + i * 8192, R, C); const int Rb = Epi::PERM ? ((R & ~31) + perm32(R & 31)) : R;
        voffA[i] = (unsigned)(R * K + C) * 2u; voffB[i] = (unsigned)(Rb * K + C) * 2u; }
    const size_t kstep = (size_t)(BK * 2);
    const size_t hstep = (size_t)HALF * K * 2;
    const size_t tstep = 2 * hstep;
    const unsigned ldsw = (unsigned)wid * 1024u;
    const int aoff = lds_byte(wr * 64 + fr, fq * 8), boff = lds_byte(wc * 32 + fr, fq * 8);
#define PG8_SA(b, h) (((b) * 2 + (h)) * HTB)
#define PG8_SB(b, h) ((4 + (b) * 2 + (h)) * HTB)
#define PG8_STAGE(bufoff, gbase, voff) do { _Pragma("unroll") for (int _i = 0; _i < 2; ++_i) \
        __builtin_amdgcn_global_load_lds((const unsigned*)((const char*)(gbase) + (voff)[_i]), (PG8_LAS unsigned*)(lds + (bufoff) + ldsw + _i * 8192), 16, 0, 0); } while (0)
#define PG8_LDA(dst, b, h) do { _Pragma("unroll") for (int m = 0; m < 4; ++m) _Pragma("unroll") for (int k = 0; k < 2; ++k) dst[m][k] = *(const PG8_LAS bf16x8*)(lds + PG8_SA(b, h) + aoff + m * 2048 + k * 1024); } while (0)
#define PG8_LDB(dst, b, h) do { _Pragma("unroll") for (int n = 0; n < 2; ++n) _Pragma("unroll") for (int k = 0; k < 2; ++k) dst[n][k] = *(const PG8_LAS bf16x8*)(lds + PG8_SB(b, h) + boff + n * 2048 + k * 1024); } while (0)
#define PG8_MMA(ai, bj, At, Bt) do { __builtin_amdgcn_s_setprio(1); _Pragma("unroll") for (int m = 0; m < 4; ++m) _Pragma("unroll") for (int n = 0; n < 2; ++n) _Pragma("unroll") for (int k = 0; k < 2; ++k) \
        acc[ai][bj][m][n] = __builtin_amdgcn_mfma_f32_16x16x32_bf16(Bt[n][k], At[m][k], acc[ai][bj][m][n], 0, 0, 0); __builtin_amdgcn_s_setprio(0); } while (0)
#define PG8_WAIT_V(n) asm volatile("s_waitcnt vmcnt(" #n ")" ::: "memory")
#define PG8_WAIT_L(n) asm volatile("s_waitcnt lgkmcnt(" #n ")" ::: "memory")
#define PG8_BAR __builtin_amdgcn_s_barrier()
#define PG8_SCHED __builtin_amdgcn_sched_barrier(0)
    Unit cur, nxt; int ui = 0;
    if (!S.next(0, cur)) return;
    f32x4 acc[2][2][4][2];
#pragma unroll
    for (int a = 0; a < 2; ++a)
#pragma unroll
        for (int b = 0; b < 2; ++b)
#pragma unroll
            for (int m = 0; m < 4; ++m)
#pragma unroll
                for (int n = 0; n < 2; ++n) acc[a][b][m][n] = (f32x4){0.f, 0.f, 0.f, 0.f};
    bf16x8 At[4][2], B0[2][2], B1[2][2];
    const char* cA = (const char*)g.A + (size_t)cur.pm * tstep; const char* cB = (const char*)g.Bt + (size_t)cur.pn * tstep;
    S.a_ready(cur);
    if constexpr (SP2) {
        PG8_STAGE(PG8_SB(0, 0), cB, voffB); PG8_STAGE(PG8_SB(0, 1), cB + hstep, voffB); PG8_STAGE(PG8_SA(0, 0), cA, voffA); PG8_STAGE(PG8_SA(0, 1), cA + hstep, voffA);
        if (wr == 1) PG8_BAR;
        PG8_WAIT_V(2); PG8_BAR;
        PG8_STAGE(PG8_SB(1, 0), cB + kstep, voffB); PG8_STAGE(PG8_SA(1, 0), cA + kstep, voffA); PG8_STAGE(PG8_SB(1, 1), cB + hstep + kstep, voffB);
        PG8_WAIT_V(6); PG8_BAR;
    } else {
        PG8_STAGE(PG8_SB(0, 0), cB, voffB); PG8_STAGE(PG8_SA(0, 0), cA, voffA); PG8_STAGE(PG8_SB(0, 1), cB + hstep, voffB); PG8_STAGE(PG8_SA(0, 1), cA + hstep, voffA);
        if (wr == 1) PG8_BAR;
        PG8_WAIT_V(4); PG8_BAR;
        PG8_STAGE(PG8_SB(1, 0), cB + kstep, voffB); PG8_STAGE(PG8_SA(1, 0), cA + kstep, voffA); PG8_STAGE(PG8_SB(1, 1), cB + hstep + kstep, voffB);
        PG8_WAIT_V(6); PG8_BAR;
    }
    for (;;) {
        const bool has_next = S.next(ui + 1, nxt);
        const char* nA = has_next ? (const char*)g.A + (size_t)nxt.pm * tstep : cA; const char* nB = has_next ? (const char*)g.Bt + (size_t)nxt.pn * tstep : cB;
        for (int t = 0; t < nt; t += 2) {
            const bool last = (t == nt - 2);
            const char* a1 = cA + (size_t)(t + 1) * kstep;
            const char* a2 = last ? nA : cA + (size_t)(t + 2) * kstep; const char* b2 = last ? nB : cB + (size_t)(t + 2) * kstep;
            const char* a3 = a2 + kstep; const char* b3 = b2 + kstep;
            if (last && has_next) S.a_ready(nxt);
            if constexpr (SP2) {
            PG8_LDB(B0, 0, 0); PG8_LDB(B1, 0, 1); PG8_SCHED; PG8_LDA(At, 0, 0); PG8_STAGE(PG8_SA(1, 1), a1 + hstep, voffA);
            PG8_WAIT_V(8); PG8_WAIT_L(0); PG8_BAR; PG8_MMA(0, 0, At, B0); PG8_MMA(0, 1, At, B1); PG8_BAR; PG8_SCHED;
            PG8_LDA(At, 0, 1); PG8_STAGE(PG8_SB(0, 0), b2, voffB); PG8_STAGE(PG8_SB(0, 1), b2 + hstep, voffB); PG8_STAGE(PG8_SA(0, 0), a2, voffA);
            PG8_WAIT_V(8); PG8_WAIT_L(0); PG8_BAR; PG8_MMA(1, 0, At, B0); PG8_MMA(1, 1, At, B1); PG8_BAR; PG8_SCHED;
            PG8_LDB(B0, 1, 0); PG8_LDB(B1, 1, 1); PG8_SCHED; PG8_LDA(At, 1, 0); PG8_STAGE(PG8_SA(0, 1), a2 + hstep, voffA);
            PG8_WAIT_V(8); PG8_WAIT_L(0); PG8_BAR; PG8_MMA(0, 0, At, B0); PG8_MMA(0, 1, At, B1); PG8_BAR; PG8_SCHED;
            PG8_LDA(At, 1, 1); PG8_STAGE(PG8_SB(1, 0), b3, voffB); PG8_STAGE(PG8_SB(1, 1), b3 + hstep, voffB); PG8_STAGE(PG8_SA(1, 0), a3, voffA);
            PG8_WAIT_V(8); PG8_WAIT_L(0); PG8_BAR; PG8_MMA(1, 0, At, B0); PG8_MMA(1, 1, At, B1); PG8_BAR; PG8_SCHED;
            } else {
            PG8_LDB(B0, 0, 0); PG8_SCHED; PG8_LDA(At, 0, 0); PG8_STAGE(PG8_SA(1, 1), a1 + hstep, voffA);
            PG8_WAIT_L(8); PG8_BAR; PG8_WAIT_L(0); PG8_MMA(0, 0, At, B0); PG8_BAR; PG8_SCHED;
            PG8_LDB(B1, 0, 1); PG8_STAGE(PG8_SB(0, 0), b2, voffB);
            PG8_BAR; PG8_WAIT_L(0); PG8_MMA(0, 1, At, B1); PG8_BAR;
            PG8_LDA(At, 0, 1); PG8_STAGE(PG8_SA(0, 0), a2, voffA);
            PG8_BAR; PG8_WAIT_L(0); PG8_MMA(1, 0, At, B0); PG8_BAR; PG8_SCHED;
            PG8_STAGE(PG8_SB(0, 1), b2 + hstep, voffB);
            PG8_WAIT_V(6); PG8_BAR; PG8_MMA(1, 1, At, B1); PG8_BAR;
            PG8_LDB(B0, 1, 0); PG8_SCHED; PG8_LDA(At, 1, 0); PG8_STAGE(PG8_SA(0, 1), a2 + hstep, voffA);
            PG8_WAIT_L(8); PG8_BAR; PG8_WAIT_L(0); PG8_MMA(0, 0, At, B0); PG8_BAR; PG8_SCHED;
            PG8_LDB(B1, 1, 1); PG8_STAGE(PG8_SB(1, 0), b3, voffB);
            PG8_BAR; PG8_WAIT_L(0); PG8_MMA(0, 1, At, B1); PG8_BAR;
            PG8_LDA(At, 1, 1); PG8_STAGE(PG8_SA(1, 0), a3, voffA);
            PG8_BAR; PG8_WAIT_L(0); PG8_MMA(1, 0, At, B0); PG8_BAR; PG8_SCHED;
            PG8_STAGE(PG8_SB(1, 1), b3 + hstep, voffB);
            PG8_WAIT_V(6); PG8_BAR; PG8_MMA(1, 1, At, B1); PG8_BAR;
            }
        }
        if constexpr (ALIGN_EPI) { if (wr == 0) PG8_BAR; }
        if constexpr (!Epi::AFTER_DRAIN) { E(acc, cur, wr, wc, fr, fq); S.done(cur); }
        if (!has_next) break;
#pragma unroll
        for (int a = 0; a < 2; ++a)
#pragma unroll
            for (int b = 0; b < 2; ++b)
#pragma unroll
                for (int m = 0; m < 4; ++m)
#pragma unroll
                    for (int n = 0; n < 2; ++n) acc[a][b][m][n] = (f32x4){0.f, 0.f, 0.f, 0.f};
        cur = nxt; cA = nA; cB = nB; ++ui;
        if constexpr (ALIGN_EPI) { if (wr == 1) PG8_BAR; }
    }
    PG8_WAIT_V(0);
    if constexpr (!ALIGN_EPI) { if (wr == 0) PG8_BAR; }
    PG8_BAR;
    if constexpr (Epi::AFTER_DRAIN) { E.fused(acc, cur, wr, wc, fr, fq, lds, wid, lane); S.done(cur); }
#undef PG8_SA
#undef PG8_SB
#undef PG8_STAGE
#undef PG8_LDA
#undef PG8_LDB
#undef PG8_MMA
#undef PG8_WAIT_V
#undef PG8_WAIT_L
#undef PG8_BAR
#undef PG8_SCHED
}
}

constexpr int NB = 4, SEQ = 8192, DM = 2048, MTOK = NB * SEQ, INC = 4608, DFF = 5632, NMODC = 6 * DM;
constexpr int NWAVES = 8, NTHR = 512;
constexpr float EPS = 1e-6f, LOG2E = 1.44269504088896f;
constexpr int O_QA = 0, O_KA = 1024, O_VA = 1280, O_QD = 1536, O_KD = 2560, O_VD = 3584;
constexpr size_t WS_MOD = 0;
constexpr size_t WS_WIN = 1u << 20;
constexpr size_t WS_WO = WS_WIN + (size_t)INC * DM * 2;
constexpr size_t WS_WGU = WS_WO + (size_t)DM * DM * 2;
constexpr size_t WS_WD = WS_WGU + (size_t)2 * DFF * DM * 2;
constexpr size_t WS_H = WS_WD + (size_t)DM * DFF * 2;
constexpr size_t WS_CAT = WS_H + (size_t)MTOK * DM * 2;
constexpr size_t WS_PROJ = WS_CAT + (size_t)MTOK * DM * 2;
constexpr size_t WS_VT = WS_PROJ + (size_t)MTOK * INC * 2;
constexpr size_t WS_KVB = WS_VT + (size_t)NB * 2 * 128 * SEQ * 2;
constexpr size_t WS_END = WS_KVB + (size_t)NB * 8 * 128 * 32768;
constexpr size_t WS_FF = WS_PROJ;
static_assert(WS_FF + (size_t)MTOK * DFF * 2 <= WS_END, "ff overlay");
constexpr int LDS_BYTES = 163840;

#define LAS __attribute__((address_space(3)))
typedef unsigned short bf16;
typedef unsigned v4u __attribute__((ext_vector_type(4)));
typedef unsigned v2u __attribute__((ext_vector_type(2)));
typedef float f32x4 __attribute__((ext_vector_type(4)));
typedef float f32x16 __attribute__((ext_vector_type(16)));
typedef short bf16x8 __attribute__((ext_vector_type(8)));
#define MFMA32(a, b, c) __builtin_amdgcn_mfma_f32_32x32x16_bf16((a), (b), (c), 0, 0, 0)
using pg8::cvtpk;

__device__ __forceinline__ float wave_sum(float v) {
#pragma unroll
    for (int o = 1; o < 64; o <<= 1) v += __shfl_xor(v, o);
    return v;
}
__device__ __forceinline__ float bf_lo(unsigned w) { return __uint_as_float(w << 16); }
__device__ __forceinline__ float bf_hi(unsigned w) { return __uint_as_float(w & 0xffff0000u); }

struct Args {
    const float *x, *c, *w_ada, *b_ada, *g1n, *w_in, *a_sink, *a_gain, *lq1, *lk1, *lq2, *lk2, *subg, *w_o, *g2n, *w_gate, *w_up, *w_down, *gfin;
    float* out; unsigned char* ws;
};

template <int MODE>
__device__ __forceinline__ void transpose_item(const float* W, int K, int N, bf16* WT, const float* ga, const float* gb, LAS float* scr, int item, int lane) {
    const int nblk = N / 32, kb = item / nblk, nb = item % nblk, k0 = 64 * kb, n0 = 32 * nb;
#pragma unroll 8
    for (int i = 0; i < 32; ++i) { const int kk = 2 * i + (lane >> 5); float v = W[(size_t)(k0 + kk) * N + n0 + (lane & 31)];
        if (MODE == 3) { const int k = k0 + kk; v *= (k < 1024) ? ga[k] : gb[(k - 1024) & 127] * 0.8f; }
        scr[kk * 33 + (lane & 31)] = v; }
    asm volatile("s_waitcnt lgkmcnt(0)" ::: "memory");
    const int c = lane & 7;
#pragma unroll
    for (int j = 0; j < 4; ++j) { const int n = (lane >> 3) + 8 * j; const LAS float* s = scr + (8 * c) * 33 + n;
        v4u o; o.x = cvtpk(s[0 * 33], s[1 * 33]); o.y = cvtpk(s[2 * 33], s[3 * 33]); o.z = cvtpk(s[4 * 33], s[5 * 33]); o.w = cvtpk(s[6 * 33], s[7 * 33]);
        const int ng = n0 + n; int dr = ng;
        if (MODE == 1) dr = (ng >> 7) * 256 + (ng & 127);
        if (MODE == 2) dr = (ng >> 7) * 256 + 128 + (ng & 127);
        *(v4u*)(WT + (size_t)dr * K + k0 + 8 * c) = o; }
    asm volatile("s_waitcnt lgkmcnt(0)" ::: "memory");
}
__device__ __forceinline__ void ada_item(const float* c, const float* w_ada, float* mod, int item, int lane) {
    const int cch = item % 48, dch = item / 48, col0 = cch * 256 + 4 * lane, d0 = dch * 64;
    float sl[4];
#pragma unroll
    for (int b = 0; b < 4; ++b) { const float cv = c[b * DM + d0 + lane]; sl[b] = cv / (1.0f + __expf(-cv)); }
    f32x4 acc[4];
#pragma unroll
    for (int b = 0; b < 4; ++b) acc[b] = (f32x4){0.f, 0.f, 0.f, 0.f};
    for (int k8 = 0; k8 < 8; ++k8) {
#pragma unroll
        for (int j = 0; j < 8; ++j) { const int kk = k8 * 8 + j;
            const f32x4 w = *(const f32x4*)(w_ada + (size_t)(d0 + kk) * NMODC + col0);
#pragma unroll
            for (int b = 0; b < 4; ++b) { const float s = __uint_as_float(__builtin_amdgcn_readlane(__float_as_uint(sl[b]), kk)); acc[b] += w * s; } }
    }
#pragma unroll
    for (int b = 0; b < 4; ++b)
#pragma unroll
        for (int e = 0; e < 4; ++e) __hip_atomic_fetch_add(mod + (size_t)b * NMODC + col0 + e, acc[b][e], __ATOMIC_RELAXED, __HIP_MEMORY_SCOPE_AGENT);
}
__device__ __forceinline__ void norm_mod_phase(const float* X, bf16* H, const float* gain, const float* mod, const float* b_ada, int sh_off, int sc_off, int gw, int ngw, int lane) {
    for (int chunk = gw; chunk < MTOK / 16; chunk += ngw) {
        const int row0 = chunk * 16, b = row0 / SEQ;
        f32x4 A[8], Bv[8];
#pragma unroll
        for (int j = 0; j < 8; ++j) { const int col = 4 * lane + 256 * j;
            const f32x4 g = *(const f32x4*)(gain + col);
            const f32x4 sc = *(const f32x4*)(mod + (size_t)b * NMODC + sc_off + col) + *(const f32x4*)(b_ada + sc_off + col);
            Bv[j] = *(const f32x4*)(mod + (size_t)b * NMODC + sh_off + col) + *(const f32x4*)(b_ada + sh_off + col);
            A[j] = g * (sc + 1.0f); }
        for (int r = 0; r < 16; ++r) {
            const f32x4* xr = (const f32x4*)(X + (size_t)(row0 + r) * DM) + lane;
            f32x4 v[8]; float ss = 0.f;
#pragma unroll
            for (int j = 0; j < 8; ++j) { v[j] = xr[64 * j]; ss += (v[j].x * v[j].x + v[j].y * v[j].y) + (v[j].z * v[j].z + v[j].w * v[j].w); }
            const float rstd = 1.0f / sqrtf(wave_sum(ss) * (1.0f / DM) + EPS);
            v2u* o8 = (v2u*)(H + (size_t)(row0 + r) * DM) + lane;
#pragma unroll
            for (int j = 0; j < 8; ++j) { const f32x4 y = v[j] * rstd * A[j] + Bv[j]; v2u w; w.x = cvtpk(y.x, y.y); w.y = cvtpk(y.z, y.w); o8[64 * j] = w; }
        }
    }
}
__device__ __forceinline__ void final_norm_phase(float* X, const float* gain, int gw, int ngw, int lane) {
    f32x4 G[8];
#pragma unroll
    for (int j = 0; j < 8; ++j) G[j] = *(const f32x4*)(gain + 4 * lane + 256 * j);
    for (int row = gw; row < MTOK; row += ngw) {
        f32x4* xr = (f32x4*)(X + (size_t)row * DM) + lane;
        f32x4 v[8]; float ss = 0.f;
#pragma unroll
        for (int j = 0; j < 8; ++j) { v[j] = xr[64 * j]; ss += (v[j].x * v[j].x + v[j].y * v[j].y) + (v[j].z * v[j].z + v[j].w * v[j].w); }
        const float rstd = 1.0f / sqrtf(wave_sum(ss) * (1.0f / DM) + EPS);
#pragma unroll
        for (int j = 0; j < 8; ++j) xr[64 * j] = v[j] * rstd * G[j];
    }
}
__device__ __forceinline__ void vt_item(const bf16* proj, bf16* VtA, unsigned char* KVB, LAS unsigned short* T, int item, int lane) {
    const int tb = item & 127, dh = (item >> 7) & 1, rest = item >> 8, vh = rest % 10, b = rest / 10;
    const int colbase = (vh < 2 ? O_VA + vh * 128 : O_VD + (vh - 2) * 128) + dh * 64, t0 = tb * 64;
#pragma unroll
    for (int i = 0; i < 8; ++i) { const int row = 8 * i + (lane >> 3), ch = lane & 7;
        const v4u v = *(const v4u*)(proj + (size_t)(b * SEQ + t0 + row) * INC + colbase + ch * 8);
        const unsigned w[4] = {v.x, v.y, v.z, v.w};
#pragma unroll
        for (int j = 0; j < 4; ++j) { T[(ch * 8 + 2 * j) * 66 + row] = (unsigned short)(w[j] & 0xffffu); T[(ch * 8 + 2 * j + 1) * 66 + row] = (unsigned short)(w[j] >> 16); } }
    asm volatile("s_waitcnt lgkmcnt(0)" ::: "memory");
#pragma unroll
    for (int i = 0; i < 8; ++i) { const int cc = 8 * i + (lane >> 3), q = lane & 7;
        const LAS unsigned* s = (const LAS unsigned*)(T + cc * 66 + q * 8);
        v4u o; o.x = s[0]; o.y = s[1]; o.z = s[2]; o.w = s[3];
        const int d = dh * 64 + cc;
        if (vh < 2) *(v4u*)(VtA + ((size_t)((b * 2 + vh) * 128 + d)) * SEQ + t0 + q * 8) = o;
        else *(v4u*)(KVB + ((size_t)((b * 8 + vh - 2) * 128 + tb)) * 32768 + 16384 + d * 128 + ((q ^ ((d >> 1) & 7)) << 4)) = o; }
    asm volatile("s_waitcnt lgkmcnt(0)" ::: "memory");
}

template <int DQK, int MODE>
__device__ __forceinline__ void attn_tile(const LAS unsigned char* Kt, const LAS unsigned char* Vtl, const bf16x8 (&qf)[DQK / 16], f32x16 (&O)[4], float& m, float& l,
                                          int qpos, int key0, float c1, float slope2, int lane) {
    constexpr int KROW = DQK * 2 + 16;
    const int r = lane & 31, hi = lane >> 5;
    const int kr = (r & 0x13) | ((r & 4) << 1) | ((r & 8) >> 1);
    f32x16 S0, S1;
#pragma unroll
    for (int t = 0; t < 16; ++t) { S0[t] = 0.f; S1[t] = 0.f; }
#pragma unroll
    for (int s = 0; s < DQK / 16; ++s) {
        const bf16x8 k0 = *(const LAS bf16x8*)(Kt + kr * KROW + s * 32 + hi * 16);
        const bf16x8 k1 = *(const LAS bf16x8*)(Kt + (32 + kr) * KROW + s * 32 + hi * 16);
        S0 = MFMA32(k0, qf[s], S0); S1 = MFMA32(k1, qf[s], S1);
    }
    float mx = -1e30f;
    const int dq = qpos - key0 - 8 * hi;
#pragma unroll
    for (int t = 0; t < 16; ++t) {
        const int d0 = dq - ((t & 7) + 16 * (t >> 3)), d1 = d0 - 32;
        const int a0 = d0 < 0 ? -d0 : d0, a1 = d1 < 0 ? -d1 : d1;
        float v0 = S0[t] - slope2 * (float)a0, v1 = S1[t] - slope2 * (float)a1;
        if (MODE == 1) { v0 = (a0 <= 128) ? v0 : -1e30f; v1 = (a1 <= 128) ? v1 : -1e30f; }
        S0[t] = v0; S1[t] = v1; mx = fmaxf(mx, fmaxf(v0, v1));
    }
    mx = fmaxf(mx, __shfl_xor(mx, 32));
    const float mnew = fmaxf(m, mx);
    if (__builtin_amdgcn_ballot_w64(mnew > m) != 0ull) {
        const float alpha = __builtin_amdgcn_exp2f(m - mnew);
        l *= alpha;
#pragma unroll
        for (int db = 0; db < 4; ++db) O[db] = O[db] * alpha;
    }
    m = mnew;
    float ps = 0.f;
#pragma unroll
    for (int t = 0; t < 16; ++t) { const float p0 = __builtin_amdgcn_exp2f(S0[t] - mnew), p1 = __builtin_amdgcn_exp2f(S1[t] - mnew); S0[t] = p0; S1[t] = p1; ps += p0 + p1; }
    l += ps;
    bf16x8 pf[4];
    { v4u w;
      w.x = cvtpk(S0[0], S0[1]); w.y = cvtpk(S0[2], S0[3]); w.z = cvtpk(S0[4], S0[5]); w.w = cvtpk(S0[6], S0[7]); pf[0] = __builtin_bit_cast(bf16x8, w);
      w.x = cvtpk(S0[8], S0[9]); w.y = cvtpk(S0[10], S0[11]); w.z = cvtpk(S0[12], S0[13]); w.w = cvtpk(S0[14], S0[15]); pf[1] = __builtin_bit_cast(bf16x8, w);
      w.x = cvtpk(S1[0], S1[1]); w.y = cvtpk(S1[2], S1[3]); w.z = cvtpk(S1[4], S1[5]); w.w = cvtpk(S1[6], S1[7]); pf[2] = __builtin_bit_cast(bf16x8, w);
      w.x = cvtpk(S1[8], S1[9]); w.y = cvtpk(S1[10], S1[11]); w.z = cvtpk(S1[12], S1[13]); w.w = cvtpk(S1[14], S1[15]); pf[3] = __builtin_bit_cast(bf16x8, w); }
#pragma unroll
    for (int db = 0; db < 4; ++db)
#pragma unroll
        for (int s4 = 0; s4 < 4; ++s4) {
            const bf16x8 vf = *(const LAS bf16x8*)(Vtl + (32 * db + r) * 144 + s4 * 32 + hi * 16);
            O[db] = MFMA32(vf, pf[s4], O[db]);
        }
}

__device__ __forceinline__ float xhalf_max(float x) { auto rr = __builtin_amdgcn_permlane32_swap(__float_as_uint(x), __float_as_uint(x), false, false); return fmaxf(__uint_as_float(rr[0]), __uint_as_float(rr[1])); }
__device__ __forceinline__ float xhalf_sum(float x) { auto rr = __builtin_amdgcn_permlane32_swap(__float_as_uint(x), __float_as_uint(x), false, false); return __uint_as_float(rr[0]) + __uint_as_float(rr[1]); }
constexpr int B_KB = 65536, B_VB = 0;
__device__ __forceinline__ void b_qk(const LAS unsigned char* Kt, const LAS unsigned char* Qw, const int (&kaddr)[4], const f32x16& ci, f32x16& S0, f32x16& S1) {
    bf16x8 kf[4], qf[4];
#pragma unroll
    for (int s = 0; s < 4; ++s) { kf[s] = *(const LAS bf16x8*)(Kt + kaddr[s]); qf[s] = *(const LAS bf16x8*)(Qw + s * 1024); }
    S0 = MFMA32(kf[0], qf[0], ci);
#pragma unroll
    for (int s = 1; s < 4; ++s) S0 = MFMA32(kf[s], qf[s], S0);
#pragma unroll
    for (int s = 0; s < 4; ++s) kf[s] = *(const LAS bf16x8*)(Kt + kaddr[s] + 4096);
    S1 = MFMA32(kf[0], qf[0], ci);
#pragma unroll
    for (int s = 1; s < 4; ++s) S1 = MFMA32(kf[s], qf[s], S1);
}
constexpr int B_QB = 131072;
#define B_WAITV(n) asm volatile("s_waitcnt vmcnt(" #n ")" ::: "memory")
#define B_BAR() do { asm volatile("s_waitcnt lgkmcnt(0)" ::: "memory"); __builtin_amdgcn_s_barrier(); asm volatile("" ::: "memory"); } while (0)
#define B_SCHED() __builtin_amdgcn_sched_barrier(0)
__device__ __forceinline__ void mfma_acc(f32x16& acc, const bf16x8& a, const bf16x8& b) { asm volatile("v_mfma_f32_32x32x16_bf16 %0, %1, %2, %0" : "+v"(acc) : "v"(a), "v"(b)); }
__device__ __forceinline__ void mfma_ini(f32x16& d, const bf16x8& a, const bf16x8& b, const f32x16& c) { asm volatile("v_mfma_f32_32x32x16_bf16 %0, %1, %2, %3" : "=&v"(d) : "v"(a), "v"(b), "v"(c)); }
__device__ __forceinline__ void exp_slice(float& p0, float& p1, float& ps, float a0, float a1, float m0, float m1) {
    asm volatile("v_sub_f32 %0, %3, %5\n\tv_sub_f32 %1, %4, %6\n\tv_exp_f32 %0, %0\n\tv_exp_f32 %1, %1\n\tv_add_f32 %2, %2, %0\n\tv_add_f32 %2, %2, %1" : "=&v"(p0), "=&v"(p1), "+v"(ps) : "v"(a0), "v"(a1), "v"(m0), "v"(m1)); }
template <int T4>
__device__ __forceinline__ void b_fstep(LAS unsigned char* lds, int t, int td, int c, int wave, const unsigned char* tile0, unsigned loff,
                                        const int (&kaddr)[4], const int (&vaddr)[4], const LAS unsigned char* Qw, f32x16& bvs, f32x16& A0, f32x16& A1, f32x16 (&O)[4], bf16x8 (&pp)[4],
                                        float& m, float& l, int qpos, int hi, float slope2) {
    constexpr int NT = SEQ / 64;
    { const int tk = (t + 3 < NT) ? t + 3 : NT - 1, tv = (t + 2 < NT) ? t + 2 : NT - 1;
      const unsigned char* kb = tile0 + (size_t)tk * 32768 + loff; const unsigned char* vb = tile0 + (size_t)tv * 32768 + 16384 + loff;
      __builtin_amdgcn_global_load_lds((const unsigned*)(kb), (LAS unsigned*)(lds + B_KB + ((T4 + 3) & 3) * 16384 + wave * 2048), 16, 0, 0);
      __builtin_amdgcn_global_load_lds((const unsigned*)(kb + 1024), (LAS unsigned*)(lds + B_KB + ((T4 + 3) & 3) * 16384 + wave * 2048 + 1024), 16, 0, 0);
      __builtin_amdgcn_global_load_lds((const unsigned*)(vb), (LAS unsigned*)(lds + B_VB + ((T4 + 2) & 3) * 16384 + wave * 2048), 16, 0, 0);
      __builtin_amdgcn_global_load_lds((const unsigned*)(vb + 1024), (LAS unsigned*)(lds + B_VB + ((T4 + 2) & 3) * 16384 + wave * 2048 + 1024), 16, 0, 0); }
    const int key0 = t * 64;
    float base, e1;
    if (t == td) {
        const int dq = qpos - key0 - 8 * hi;
#pragma unroll
        for (int r = 0; r < 16; ++r) { const int d0 = dq - ((r & 7) + 16 * (r >> 3)), d1 = d0 - 32;
            const int a0 = d0 < 0 ? -d0 : d0, a1 = d1 < 0 ? -d1 : d1;
            A0[r] = A0[r] - bvs[r] - slope2 * (float)a0; A1[r] = A1[r] - bvs[r] - slope2 * (float)a1; }
        bvs = -bvs; base = 0.f; e1 = 0.f;
    } else { const float sg = (t < td) ? slope2 : -slope2; base = sg * (float)(key0 + 8 * hi - qpos); e1 = sg * 32.0f; }
    B_SCHED();
    const LAS unsigned char* Vb = lds + B_VB + ((T4 + 3) & 3) * 16384;
    const LAS unsigned char* Kt = lds + ((T4 + 1) & 3) * 16384;
    f32x16 N0, N1;
    bf16x8 fa[4], fb[4], qf[4];
    float mx0 = -1e30f, mx1 = -1e30f, mnew = m, alpha = 1.0f, mr0 = 0.f, mr1 = 0.f, ps = 0.f;
    v4u w0, w1;
#pragma unroll
    for (int s4 = 0; s4 < 4; ++s4) fa[s4] = *(const LAS bf16x8*)(Vb + vaddr[s4]);
    B_SCHED();
#pragma unroll
    for (int i = 0; i < 24; ++i) {
        const int g = i >> 2, j = i & 3;
        if (j == 0) {
            if (g == 0) {
#pragma unroll
                for (int s4 = 0; s4 < 4; ++s4) fb[s4] = *(const LAS bf16x8*)(Vb + vaddr[s4] + 4096); }
            if (g == 1) {
#pragma unroll
                for (int s4 = 0; s4 < 4; ++s4) fa[s4] = *(const LAS bf16x8*)(Vb + vaddr[s4] + 8192); }
            if (g == 2) {
#pragma unroll
                for (int s4 = 0; s4 < 4; ++s4) fb[s4] = *(const LAS bf16x8*)(Vb + vaddr[s4] + 12288); }
            if (g == 3) {
#pragma unroll
                for (int s4 = 0; s4 < 4; ++s4) { fa[s4] = *(const LAS bf16x8*)(Kt + kaddr[s4]); qf[s4] = *(const LAS bf16x8*)(Qw + s4 * 1024); } }
            if (g == 4) {
#pragma unroll
                for (int s4 = 0; s4 < 4; ++s4) fb[s4] = *(const LAS bf16x8*)(Kt + kaddr[s4] + 4096); }
        }
        if (g == 0) mfma_acc(O[0], fa[j], pp[j]);
        if (g == 1) mfma_acc(O[1], fb[j], pp[j]);
        if (g == 2) mfma_acc(O[2], fa[j], pp[j]);
        if (g == 3) mfma_acc(O[3], fb[j], pp[j]);
        if (g == 4) { if (j == 0) N0 = MFMA32(fa[0], qf[0], bvs); else mfma_acc(N0, fa[j], qf[j]); }
        if (g == 5) { if (j == 0) N1 = MFMA32(fb[0], qf[0], bvs); else mfma_acc(N1, fb[j], qf[j]); }
        if (i < 4) {
#pragma unroll
            for (int r = 4 * i; r < 4 * i + 4; ++r) { mx0 = fmaxf(mx0, A0[r]); mx1 = fmaxf(mx1, A1[r]); } }
        if (i == 4) { const float mx = xhalf_max(fmaxf(mx0, mx1 + e1) + base); mnew = (mx > m + 6.0f) ? mx : m; alpha = __builtin_amdgcn_exp2f(m - mnew);     mr0 = mnew - base; mr1 = mr0 - e1; }
        if (i >= 5 && i < 13) { const int r = 2 * (i - 5); float x0, x1; exp_slice(x0, x1, ps, A0[r], A0[r + 1], mr0, mr0); A0[r] = x0; A0[r + 1] = x1; }
        if (i == 13) { w0.x = cvtpk(A0[0], A0[1]); w0.y = cvtpk(A0[2], A0[3]); w0.z = cvtpk(A0[4], A0[5]); w0.w = cvtpk(A0[6], A0[7]);
                       w1.x = cvtpk(A0[8], A0[9]); w1.y = cvtpk(A0[10], A0[11]); w1.z = cvtpk(A0[12], A0[13]); w1.w = cvtpk(A0[14], A0[15]); }
        if (i >= 13 && i < 21) { const int r = 2 * (i - 13); float x0, x1; exp_slice(x0, x1, ps, A1[r], A1[r + 1], mr1, mr1); A1[r] = x0; A1[r + 1] = x1; }
        if (i == 21) { v4u w2, w3; w2.x = cvtpk(A1[0], A1[1]); w2.y = cvtpk(A1[2], A1[3]); w2.z = cvtpk(A1[4], A1[5]); w2.w = cvtpk(A1[6], A1[7]); pp[2] = __builtin_bit_cast(bf16x8, w2);
                       w3.x = cvtpk(A1[8], A1[9]); w3.y = cvtpk(A1[10], A1[11]); w3.z = cvtpk(A1[12], A1[13]); w3.w = cvtpk(A1[14], A1[15]); pp[3] = __builtin_bit_cast(bf16x8, w3); }
        if (i == 22) { pp[0] = __builtin_bit_cast(bf16x8, w0); pp[1] = __builtin_bit_cast(bf16x8, w1); }
        B_SCHED();
    }
    asm volatile("s_nop 15");
    if (__builtin_amdgcn_ballot_w64(mnew > m) != 0ull) {
#pragma unroll
        for (int db = 0; db < 4; ++db) O[db] = O[db] * alpha;
    }
    l = l * alpha + ps; m = mnew;
    A0 = N0; A1 = N1;
    B_WAITV(6); B_BAR();
}
__device__ __forceinline__ void attn_unit_B(LAS unsigned char* lds, const bf16* proj, const unsigned char* KVB, bf16* cat, int b, int h, int qb, float lam, int tid, int wave, int lane) {
    asm volatile("" : "+v"(lane));
    const int c = wave >> 2, sb = wave & 3, r = lane & 31, hi = lane >> 5;
    const int q0 = qb * 128 + sb * 32, qpos = q0 + r, td = q0 >> 6;
    const size_t rowbase = (size_t)b * SEQ;
    LAS unsigned char* Qw = lds + B_QB + wave * 4096 + lane * 16;
#pragma unroll
    for (int s = 0; s < 4; ++s) *(LAS bf16x8*)(Qw + s * 1024) = *(const bf16x8*)(proj + (rowbase + qpos) * INC + O_QD + h * 128 + c * 64 + 16 * s + 8 * hi);
    { const v4u z = {0u, 0u, 0u, 0u}; *(LAS v4u*)(lds + B_VB + 3 * 16384 + tid * 32) = z; *(LAS v4u*)(lds + B_VB + 3 * 16384 + tid * 32 + 16) = z; }
    f32x16 O[4];
#pragma unroll
    for (int db = 0; db < 4; ++db)
#pragma unroll
        for (int t = 0; t < 16; ++t) O[db][t] = 0.f;
    float m = -1e30f, l = 0.f;
    const float slope2 = __builtin_amdgcn_exp2f(-0.5f * (float)(9 + h)) * LOG2E;
    f32x16 bvs;
#pragma unroll
    for (int t = 0; t < 16; ++t) bvs[t] = slope2 * (float)((t & 7) + 16 * (t >> 3));
    const int kr = (r & 0x13) | ((r & 4) << 1) | ((r & 8) >> 1), kk = (kr >> 1) & 7, vk = (r >> 1) & 7;
    int kaddr[4], vaddr[4];
#pragma unroll
    for (int s = 0; s < 4; ++s) { kaddr[s] = B_KB + c * 8192 + kr * 128 + (((2 * s + hi) ^ kk) << 4); vaddr[s] = r * 128 + (((2 * s + hi) ^ vk) << 4); }
    const unsigned char* tile0 = KVB + ((size_t)((b * 8 + h) * 128)) * 32768;
    const unsigned loff = (unsigned)(wave * 2048 + lane * 16);
    const unsigned char* ks0 = tile0 + loff;
    const unsigned char* ks1 = ks0 + 1024;
    const unsigned char* vs0 = ks0 + 16384;
    const unsigned char* vs1 = vs0 + 1024;
#pragma unroll
    for (int i = 0; i < 3; ++i) {
        __builtin_amdgcn_global_load_lds((const unsigned*)(ks0 + i * 32768), (LAS unsigned*)(lds + B_KB + i * 16384 + wave * 2048), 16, 0, 0);
        __builtin_amdgcn_global_load_lds((const unsigned*)(ks1 + i * 32768), (LAS unsigned*)(lds + B_KB + i * 16384 + wave * 2048 + 1024), 16, 0, 0);
        if (i < 2) {
        __builtin_amdgcn_global_load_lds((const unsigned*)(vs0 + i * 32768), (LAS unsigned*)(lds + B_VB + i * 16384 + wave * 2048), 16, 0, 0);
        __builtin_amdgcn_global_load_lds((const unsigned*)(vs1 + i * 32768), (LAS unsigned*)(lds + B_VB + i * 16384 + wave * 2048 + 1024), 16, 0, 0); }
    }
    B_WAITV(0); B_BAR();
    f32x16 A0, A1;
    b_qk(lds, Qw, kaddr, bvs, A0, A1);
    B_BAR();
    bf16x8 pp[4];
#pragma unroll
    for (int s4 = 0; s4 < 4; ++s4) pp[s4] = (bf16x8){0, 0, 0, 0, 0, 0, 0, 0};
    for (int t = 0; t < SEQ / 64; t += 4) {
        b_fstep<0>(lds, t, td, c, wave, tile0, loff, kaddr, vaddr, Qw, bvs, A0, A1, O, pp, m, l, qpos, hi, slope2);
        b_fstep<1>(lds, t + 1, td, c, wave, tile0, loff, kaddr, vaddr, Qw, bvs, A0, A1, O, pp, m, l, qpos, hi, slope2);
        b_fstep<2>(lds, t + 2, td, c, wave, tile0, loff, kaddr, vaddr, Qw, bvs, A0, A1, O, pp, m, l, qpos, hi, slope2);
        b_fstep<3>(lds, t + 3, td, c, wave, tile0, loff, kaddr, vaddr, Qw, bvs, A0, A1, O, pp, m, l, qpos, hi, slope2);
    }
    {
        const LAS unsigned char* Vb = lds + B_VB + ((SEQ / 64 - 1) & 3) * 16384;
#pragma unroll
        for (int db = 0; db < 4; ++db) {
            bf16x8 vf[4];
#pragma unroll
            for (int s4 = 0; s4 < 4; ++s4) vf[s4] = *(const LAS bf16x8*)(Vb + vaddr[s4] + db * 4096);
#pragma unroll
            for (int s4 = 0; s4 < 4; ++s4) O[db] = MFMA32(vf[s4], pp[s4], O[db]);
        }
    }
    B_WAITV(0); B_BAR();
    l = xhalf_sum(l);
    const float inv = 1.0f / l;
    LAS float* X = (LAS float*)lds;
    if (c == 1) {
#pragma unroll
        for (int db = 0; db < 4; ++db)
#pragma unroll
            for (int t = 0; t < 16; ++t) X[(sb * 64 + db * 16 + t) * 64 + lane] = O[db][t] * inv;
    }
    __syncthreads();
    if (c == 0) {
        float ss = 0.f;
#pragma unroll
        for (int db = 0; db < 4; ++db)
#pragma unroll
            for (int t = 0; t < 16; ++t) { const float o = O[db][t] * inv - lam * X[(sb * 64 + db * 16 + t) * 64 + lane]; O[db][t] = o; ss += o * o; }
        ss = xhalf_sum(ss);
        const float rstd = 1.0f / sqrtf(ss * (1.0f / 128.0f) + EPS);
        bf16* orow = cat + (rowbase + qpos) * DM + 1024 + h * 128 + 4 * hi;
#pragma unroll
        for (int db = 0; db < 4; ++db)
#pragma unroll
            for (int g = 0; g < 4; ++g) { v2u w; w.x = cvtpk(O[db][4 * g] * rstd, O[db][4 * g + 1] * rstd); w.y = cvtpk(O[db][4 * g + 2] * rstd, O[db][4 * g + 3] * rstd);
                *(v2u*)(orow + 32 * db + 8 * g) = w; }
    }
    __syncthreads();
}

constexpr int A_KT = 64 * 272, A_VOFF = 2 * A_KT, A_SSQ = A_VOFF + 2 * 18432;
__device__ __forceinline__ void attn_unit_A(LAS unsigned char* lds, const bf16* proj, const bf16* VtAll, bf16* cat, const float* a_sink, int b, int n, int tid, int wave, int lane) {
    asm volatile("" : "+v"(lane), "+v"(tid));
    const int w = wave, g = w >> 2, r = lane & 31, hi = lane >> 5;
    const size_t rowbase = (size_t)b * SEQ;
    const float c1 = 0.08838834764831845f * LOG2E, slope2 = __builtin_amdgcn_exp2f(-0.5f * (float)(w + 1)) * LOG2E, sinkv = a_sink[w] * LOG2E;
    LAS float* ssq = (LAS float*)(lds + A_SSQ);
    for (int sbk = 0; sbk < 4; ++sbk) {
        const int p0 = n * 128 + sbk * 32, qpos = p0 + r;
        bf16x8 qf[8];
#pragma unroll
        for (int s = 0; s < 8; ++s) qf[s] = *(const bf16x8*)(proj + (rowbase + qpos) * INC + O_QA + w * 128 + 16 * s + 8 * hi);
        f32x16 O[4];
#pragma unroll
        for (int db = 0; db < 4; ++db)
#pragma unroll
            for (int t = 0; t < 16; ++t) O[db][t] = 0.f;
        float m = sinkv, l = (hi == 0) ? 1.0f : 0.0f;
        const int ts = ((p0 - 128) >> 6) << 6;
        for (int i = 0; i < 5; ++i) {
            const int key0 = ts + 64 * i;
            if (key0 < 0 || key0 >= SEQ) continue;
            __syncthreads();
#pragma unroll
            for (int j = 0; j < 4; ++j) { const int idx = tid + 512 * j, gk = idx >> 10, rem = idx & 1023;
                { const int row = rem >> 4, ch = rem & 15;
                  const v4u v = *(const v4u*)(proj + (rowbase + key0 + row) * INC + O_KA + gk * 128 + ch * 8);
                  *(LAS v4u*)(lds + gk * A_KT + row * 272 + ch * 16) = v; }
                { const int d = rem >> 3, ch = rem & 7;
                  const v4u v = *(const v4u*)(VtAll + ((size_t)((b * 2 + gk) * 128 + d)) * SEQ + key0 + ch * 8);
                  *(LAS v4u*)(lds + A_VOFF + gk * 18432 + d * 144 + ch * 16) = v; } }
            __syncthreads();
            attn_tile<128, 1>(lds + g * A_KT, lds + A_VOFF + g * 18432, qf, O, m, l, qpos, key0, c1, slope2, lane);
        }
        l += __shfl_xor(l, 32);
        const float inv = 1.0f / l;
        float ss = 0.f;
#pragma unroll
        for (int db = 0; db < 4; ++db)
#pragma unroll
            for (int t = 0; t < 16; ++t) { const float o = O[db][t] * inv; O[db][t] = o; ss += o * o; }
        ss += __shfl_xor(ss, 32);
        if (hi == 0) ssq[w * 128 + sbk * 32 + r] = ss;
        bf16* orow = cat + (rowbase + qpos) * DM + w * 128 + 4 * hi;
#pragma unroll
        for (int db = 0; db < 4; ++db)
#pragma unroll
            for (int gq = 0; gq < 4; ++gq) { v2u ww; ww.x = cvtpk(O[db][4 * gq], O[db][4 * gq + 1]); ww.y = cvtpk(O[db][4 * gq + 2], O[db][4 * gq + 3]);
                *(v2u*)(orow + 32 * db + 8 * gq) = ww; }
    }
    __syncthreads();
    for (int sbk = 0; sbk < 4; ++sbk) {
        const int ql = sbk * 32 + r;
        float tot = 0.f;
#pragma unroll
        for (int w2 = 0; w2 < 8; ++w2) tot += ssq[w2 * 128 + ql];
        const float rstd = 1.0f / sqrtf(tot * (1.0f / 1024.0f) + EPS);
        bf16* orow = cat + (rowbase + n * 128 + ql) * DM + w * 128 + 4 * hi;
#pragma unroll
        for (int db = 0; db < 4; ++db)
#pragma unroll
            for (int gq = 0; gq < 4; ++gq) { v2u* p = (v2u*)(orow + 32 * db + 8 * gq); const v2u ww = *p;
                v2u o; o.x = cvtpk(bf_lo(ww.x) * rstd, bf_hi(ww.x) * rstd); o.y = cvtpk(bf_lo(ww.y) * rstd, bf_hi(ww.y) * rstd); *p = o; }
    }
    __syncthreads();
}

__global__ void __launch_bounds__(NTHR, 2) fwd_mega(Args a) {
    extern __shared__ __attribute__((aligned(16))) unsigned char lds_raw[];
    LAS unsigned char* lds = (LAS unsigned char*)lds_raw;
    cg::grid_group grid = cg::this_grid();
    int tid = threadIdx.x, lane = tid & 63; const int wave = __builtin_amdgcn_readfirstlane(tid >> 6);
#define FRESH_LANE() asm volatile("" : "+v"(lane), "+v"(tid))
    const int G = gridDim.x, bx = blockIdx.x;
    const int gw = bx * NWAVES + wave, ngw = G * NWAVES;
    unsigned char* ws = a.ws;
    float* mod = (float*)(ws + WS_MOD);
    bf16* Win_t = (bf16*)(ws + WS_WIN); bf16* Wo_t = (bf16*)(ws + WS_WO); bf16* Wgu_t = (bf16*)(ws + WS_WGU); bf16* Wd_t = (bf16*)(ws + WS_WD);
    bf16* Hb = (bf16*)(ws + WS_H); bf16* cat = (bf16*)(ws + WS_CAT); bf16* proj = (bf16*)(ws + WS_PROJ); bf16* VtAll = (bf16*)(ws + WS_VT); unsigned char* KVB = ws + WS_KVB; bf16* FFb = (bf16*)(ws + WS_FF);

    FRESH_LANE();
    {
        for (int it = gw; it < 48 * 32; it += ngw) ada_item(a.c, a.w_ada, mod, it, lane);
        LAS float* scr = (LAS float*)(lds + wave * 16384);
        constexpr int I_IN = (DM / 64) * (INC / 32), I_O = (DM / 64) * (DM / 32), I_G = (DM / 64) * (DFF / 32), I_D = (DFF / 64) * (DM / 32);
        constexpr int NIT = I_IN + I_O + 2 * I_G + I_D;
        for (int it = gw; it < NIT; it += ngw) {
            int r = it;
            if (r < I_IN) { transpose_item<0>(a.w_in, DM, INC, Win_t, nullptr, nullptr, scr, r, lane); continue; } r -= I_IN;
            if (r < I_O) { transpose_item<3>(a.w_o, DM, DM, Wo_t, a.a_gain, a.subg, scr, r, lane); continue; } r -= I_O;
            if (r < I_G) { transpose_item<1>(a.w_gate, DM, DFF, Wgu_t, nullptr, nullptr, scr, r, lane); continue; } r -= I_G;
            if (r < I_G) { transpose_item<2>(a.w_up, DM, DFF, Wgu_t, nullptr, nullptr, scr, r, lane); continue; } r -= I_G;
            transpose_item<0>(a.w_down, DFF, DM, Wd_t, nullptr, nullptr, scr, r, lane);
        }
    }
    grid.sync();
    FRESH_LANE();
    norm_mod_phase(a.x, Hb, a.g1n, mod, a.b_ada, 0, DM, gw, ngw, lane);
    grid.sync();
    {
        pg8::Gemm g{Hb, Win_t, MTOK, INC, DM}; pg8::StaticOrder S; S.init(MTOK, INC, G, bx);
        pg8::EpiStoreBf16 E{proj, INC, 0.08838834764831845f * LOG2E, 0.125f * LOG2E, KVB};
        pg8::gemm_phase<pg8::EpiStoreBf16, pg8::StaticOrder, true, true>(lds, g, S, E);
    }
    grid.sync();
    FRESH_LANE();
    {
        LAS unsigned short* T = (LAS unsigned short*)(lds + wave * 8448);
        for (int it = gw; it < NB * 10 * 2 * 128; it += ngw) vt_item(proj, VtAll, KVB, T, it, lane);
    }
    grid.sync();
    FRESH_LANE();
    {
        float s1 = 0.f, s2 = 0.f;
        for (int i = 0; i < 64; ++i) { s1 += a.lq1[i] * a.lk1[i]; s2 += a.lq2[i] * a.lk2[i]; }
        const float lam = __expf(s1) - __expf(s2) + 0.2f;
        for (int u = bx; u < NB * 64; u += G) attn_unit_A(lds, proj, VtAll, cat, a.a_sink, u >> 6, u & 63, tid, wave, lane);
        for (int v = bx; v < NB * 8 * 64; v += G) {
            const int xcd = v & 7, j = v >> 3, idx = j & 31, rnd = j >> 5;
            const int bh = xcd * 4 + (rnd >> 1), qb = (rnd & 1) * 32 + idx;
            attn_unit_B(lds, proj, KVB, cat, bh >> 3, bh & 7, qb, lam, tid, wave, lane);
        }
    }
    grid.sync();
    {
        pg8::Gemm g{cat, Wo_t, MTOK, DM, DM}; pg8::StaticOrder S; S.init(MTOK, DM, G, bx);
        pg8::EpiResGate E{a.x, a.out, DM, mod + 2 * DM, a.b_ada + 2 * DM};
        pg8::gemm_phase<pg8::EpiResGate, pg8::StaticOrder, true, true>(lds, g, S, E);
    }
    grid.sync();
    FRESH_LANE();
    norm_mod_phase(a.out, Hb, a.g2n, mod, a.b_ada, 3 * DM, 4 * DM, gw, ngw, lane);
    grid.sync();
    {
        pg8::Gemm g{Hb, Wgu_t, MTOK, 2 * DFF, DM}; pg8::StaticOrder S; S.init(MTOK, 2 * DFF, G, bx);
        pg8::EpiSwiGLU E{FFb, DFF};
        pg8::gemm_phase<pg8::EpiSwiGLU, pg8::StaticOrder, true, true>(lds, g, S, E);
    }
    grid.sync();
    {
        pg8::Gemm g{FFb, Wd_t, MTOK, DM, DFF}; pg8::StaticOrder S; S.init(MTOK, DM, G, bx);
        pg8::EpiResGate E{a.out, a.out, DM, mod + 5 * DM, a.b_ada + 5 * DM};
        pg8::gemm_phase<pg8::EpiResGate, pg8::StaticOrder, true, true>(lds, g, S, E);
    }
    grid.sync();
    FRESH_LANE();
    final_norm_phase(a.out, a.gfin, gw, ngw, lane);
}

extern "C" void kernel_launch(void* const* d_in, const int* in_sizes, int n_in, void* d_out, int out_size, void* d_ws, size_t ws_size, hipStream_t stream) {
    static int grid = 0;
    if (grid == 0) {
        if (n_in != 19 || in_sizes[0] != MTOK * DM || out_size != MTOK * DM || ws_size < WS_END) {
            fprintf(stderr, "kernel_launch: unexpected shapes (n_in %d, in0 %d, out %d, ws %zu; need ws >= %zu)\n", n_in, n_in > 0 ? in_sizes[0] : -1, out_size, ws_size, (size_t)WS_END); grid = -1; return; }
        int dev = 0, cus = 0, per_cu = 0;
        if (hipGetDevice(&dev) != hipSuccess || hipDeviceGetAttribute(&cus, hipDeviceAttributeMultiprocessorCount, dev) != hipSuccess) { grid = -1; return; }
        if (hipFuncSetAttribute((const void*)fwd_mega, hipFuncAttributeMaxDynamicSharedMemorySize, LDS_BYTES) != hipSuccess) { fprintf(stderr, "kernel_launch: hipFuncSetAttribute failed\n"); grid = -1; return; }
        if (hipOccupancyMaxActiveBlocksPerMultiprocessor(&per_cu, (const void*)fwd_mega, NTHR, LDS_BYTES) != hipSuccess || per_cu < 1) { fprintf(stderr, "kernel_launch: occupancy query says %d\n", per_cu); per_cu = 1; }
        (void)hipGetLastError();
        grid = cus;
    }
    if (grid < 0) return;
    (void)hipMemsetAsync((char*)d_ws + WS_MOD, 0, (size_t)NB * NMODC * 4, stream);
    Args a{};
    a.x = (const float*)d_in[0]; a.c = (const float*)d_in[1]; a.w_ada = (const float*)d_in[2]; a.b_ada = (const float*)d_in[3]; a.g1n = (const float*)d_in[4];
    a.w_in = (const float*)d_in[5]; a.a_sink = (const float*)d_in[6]; a.a_gain = (const float*)d_in[7]; a.lq1 = (const float*)d_in[8]; a.lk1 = (const float*)d_in[9];
    a.lq2 = (const float*)d_in[10]; a.lk2 = (const float*)d_in[11]; a.subg = (const float*)d_in[12]; a.w_o = (const float*)d_in[13]; a.g2n = (const float*)d_in[14];
    a.w_gate = (const float*)d_in[15]; a.w_up = (const float*)d_in[16]; a.w_down = (const float*)d_in[17]; a.gfin = (const float*)d_in[18];
    a.out = (float*)d_out; a.ws = (unsigned char*)d_ws;
    void* args[] = {&a};
    const hipError_t e = hipLaunchCooperativeKernel((const void*)fwd_mega, dim3(grid), dim3(NTHR), args, LDS_BYTES, stream);
    if (e != hipSuccess) fprintf(stderr, "kernel_launch: cooperative launch failed: %s (grid %d)\n", hipGetErrorString(e), grid);
}
```

```cpp
#include <hip/hip_runtime.h>
#include <hip/hip_cooperative_groups.h>
#include <cstdio>
#include <cstdint>
namespace cg = cooperative_groups;
namespace pg8 {
#define PG8_LAS __attribute__((address_space(3)))
typedef unsigned short bf16_t;
typedef short bf16x8 __attribute__((ext_vector_type(8)));
typedef float f32x4 __attribute__((ext_vector_type(4)));
typedef unsigned u32x4 __attribute__((ext_vector_type(4)));
constexpr int BM = 256, BK = 64, HALF = 128, HTB = HALF * BK * 2  , STAGE_BYTES = 8 * HTB, NXCD = 8, WGM = 8;

__host__ __device__ __forceinline__ int lds_byte(int r, int c) { const int st = (r >> 4) * 2 + (c >> 5), rr = r & 15, cc = c & 31, ob = rr * 64 + cc * 2; return st * 1024 + (ob ^ (((ob >> 9) & 1) << 5)); }
__host__ __device__ __forceinline__ void stage_rc(int b, int& R, int& C) { const int st = b / 1024, sb = b % 1024, swz = sb ^ (((sb >> 9) & 1) << 5); R = (st >> 1) * 16 + swz / 64; C = (st & 1) * 32 + (swz % 64) / 2; }
__host__ __device__ __forceinline__ int perm32(int rho) { const int n = rho >> 4, i = rho & 15; return 8 * (i >> 2) + 4 * n + (i & 3); }

struct Unit { int pm, pn; };
struct Gemm { const bf16_t* A; const bf16_t* Bt; int M, N, K; };

struct StaticOrder {
    int nM, nN, nwg, G, c;
    __host__ __device__ void init(int M, int N, int G_, int c_) { nM = M / BM; nN = N / BM; nwg = nM * nN; G = G_; c = c_; }
    __host__ __device__ bool next(int i, Unit& u) const {
        const long L = (long)i * G + c; if (L >= nwg) return false;
        int wgid = (int)L; { const int q = nwg / NXCD, r = nwg % NXCD, xcd = wgid % NXCD, off = wgid / NXCD; wgid = (xcd < r ? xcd * (q + 1) : r * (q + 1) + (xcd - r) * q) + off; }
        const int nig = WGM * nN, gid = wgid / nig, fm = gid * WGM, gsz = (nM - fm) < WGM ? (nM - fm) : WGM;
        u.pm = fm + ((wgid % nig) % gsz); u.pn = (wgid % nig) / gsz; return true;
    }
    __device__ __forceinline__ void a_ready(const Unit&) const {}
    __device__ __forceinline__ void done(const Unit&) const {}
};
__device__ __forceinline__ unsigned cvt_pk_bf16(float lo, float hi) { unsigned r; asm volatile("v_cvt_pk_bf16_f32 %0, %1, %2" : "=v"(r) : "v"(lo), "v"(hi)); return r; }
typedef float f32x2 __attribute__((ext_vector_type(2)));
typedef __bf16 bf16x2v __attribute__((ext_vector_type(2)));
__device__ __forceinline__ unsigned cvtpk(float lo, float hi) { f32x2 v = {lo, hi}; bf16x2v b = __builtin_convertvector(v, bf16x2v); return __builtin_bit_cast(unsigned, b); }

struct EpiStoreBf16 {
    static constexpr bool PERM = true, AFTER_DRAIN = false;
    bf16_t* O; int ldc; float scA, scB; unsigned char* kvb;
    __device__ __forceinline__ void operator()(const f32x4 (&acc)[2][2][4][2], const Unit& u, int wr, int wc, int fr, int fq) const {
        const int row0 = u.pm * BM + wr * 64 + fr, col0 = u.pn * BM + wc * 32 + 8 * fq;
        const float sc = (u.pn < 4) ? scA : ((u.pn >= 6 && u.pn < 10) ? scB : 1.0f);
        const bool kd = (u.pn >= 10 && u.pn < 14);
#pragma unroll
        for (int ai = 0; ai < 2; ++ai)
#pragma unroll
            for (int m = 0; m < 4; ++m) { const int row = row0 + ai * HALF + m * 16; bf16_t* rowp = O + (size_t)row * ldc + col0;
                const int b = row >> 13, tok = row & 8191, rr = tok & 63;
                unsigned char* kp = kvb + ((size_t)((b * 8 + 2 * (u.pn - 10)) * 128 + (tok >> 6))) * 32768 + (wc >> 1) * 8192 + rr * 128 + ((((wc & 1) * 4 + fq) ^ ((rr >> 1) & 7)) << 4);
#pragma unroll
                for (int bj = 0; bj < 2; ++bj) { const f32x4 v0 = acc[ai][bj][m][0] * sc, v1 = acc[ai][bj][m][1] * sc;
                    u32x4 w; w.x = cvtpk(v0[0], v0[1]); w.y = cvtpk(v0[2], v0[3]); w.z = cvtpk(v1[0], v1[1]); w.w = cvtpk(v1[2], v1[3]);
                    if (kd) *(u32x4*)(kp + (size_t)bj * 128 * 32768) = w; else *(u32x4*)(rowp + bj * HALF) = w; } }
    }
};
struct EpiResGate {
    static constexpr bool PERM = false, AFTER_DRAIN = false;
    const float* base; float* out; int ldc; const float* modg; const float* badag;
    __device__ __forceinline__ void operator()(const f32x4 (&acc)[2][2][4][2], const Unit& u, int wr, int wc, int fr, int fq) const {
        const int row0 = u.pm * BM + wr * 64 + fr, col0 = u.pn * BM + wc * 32 + 4 * fq, b = u.pm >> 5;
        f32x4 gv[2][2];
#pragma unroll
        for (int bj = 0; bj < 2; ++bj)
#pragma unroll
            for (int n = 0; n < 2; ++n) gv[bj][n] = *(const f32x4*)(modg + (size_t)b * 12288 + col0 + bj * HALF + n * 16) + *(const f32x4*)(badag + col0 + bj * HALF + n * 16);
#pragma unroll
        for (int ai = 0; ai < 2; ++ai)
#pragma unroll
            for (int m = 0; m < 4; ++m) { const size_t off = (size_t)(row0 + ai * HALF + m * 16) * ldc + col0;
#pragma unroll
                for (int bj = 0; bj < 2; ++bj)
#pragma unroll
                    for (int n = 0; n < 2; ++n) { const f32x4 bs = *(const f32x4*)(base + off + bj * HALF + n * 16);
                        *(f32x4*)(out + off + bj * HALF + n * 16) = bs + gv[bj][n] * acc[ai][bj][m][n]; }
                asm volatile("" ::: "memory"); }
    }
};
struct EpiSwiGLU {
    static constexpr bool PERM = true, AFTER_DRAIN = false;
    bf16_t* O; int ldc;
    static __device__ __forceinline__ float sw(float g, float up) { return g * __builtin_amdgcn_rcpf(1.0f + __builtin_amdgcn_exp2f(-1.44269504f * g)) * up; }
    __device__ __forceinline__ void operator()(const f32x4 (&acc)[2][2][4][2], const Unit& u, int wr, int wc, int fr, int fq) const {
        const int row0 = u.pm * BM + wr * 64 + fr, col0 = u.pn * HALF + wc * 32 + 8 * fq;
#pragma unroll
        for (int ai = 0; ai < 2; ++ai)
#pragma unroll
            for (int m = 0; m < 4; ++m) { bf16_t* rowp = O + (size_t)(row0 + ai * HALF + m * 16) * ldc + col0;
                const f32x4 g0 = acc[ai][0][m][0], g1 = acc[ai][0][m][1], u0 = acc[ai][1][m][0], u1 = acc[ai][1][m][1];
                u32x4 w; w.x = cvtpk(sw(g0[0], u0[0]), sw(g0[1], u0[1])); w.y = cvtpk(sw(g0[2], u0[2]), sw(g0[3], u0[3]));
                w.z = cvtpk(sw(g1[0], u1[0]), sw(g1[1], u1[1])); w.w = cvtpk(sw(g1[2], u1[2]), sw(g1[3], u1[3]));
                *(u32x4*)rowp = w; }
    }
};

template <class Epi, class Sched, bool ALIGN_EPI = false, bool SP2 = false>
__device__ __forceinline__ void gemm_phase(PG8_LAS unsigned char* lds, const Gemm g, const Sched& S, const Epi& E) {
    int tid_ = threadIdx.x; asm volatile("" : "+v"(tid_));
    const int tid = tid_, wid = __builtin_amdgcn_readfirstlane(tid >> 6), lane = tid & 63, wr = wid >> 2, wc = wid & 3, fr = lane & 15, fq = lane >> 4;
    const int K = g.K, nt = K / BK;
    unsigned voffA[2], voffB[2];
#pragma unroll
    for (int i = 0; i < 2; ++i) { int R, C; stage_rc(tid * 16 + i * 8192, R, C); const int Rb = Epi::PERM ? ((R & ~31) + perm32(R & 31)) : R;
        voffA[i] = (unsigned)(R * K + C) * 2u; voffB[i] = (unsigned)(Rb * K + C) * 2u; }
    const size_t kstep = (size_t)(BK * 2);
    const size_t hstep = (size_t)HALF * K * 2;
    const size_t tstep = 2 * hstep;
    const unsigned ldsw = (unsigned)wid * 1024u;
    const int aoff = lds_byte(wr * 64 + fr, fq * 8), boff = lds_byte(wc * 32 + fr, fq * 8);
#define PG8_SA(b, h) (((b) * 2 + (h)) * HTB)
#define PG8_SB(b, h) ((4 + (b) * 2 + (h)) * HTB)
#define PG8_STAGE(bufoff, gbase, voff) do { _Pragma("unroll") for (int _i = 0; _i < 2; ++_i) \
        __builtin_amdgcn_global_load_lds((const unsigned*)((const char*)(gbase) + (voff)[_i]), (PG8_LAS unsigned*)(lds + (bufoff) + ldsw + _i * 8192), 16, 0, 0); } while (0)
#define PG8_LDA(dst, b, h) do { _Pragma("unroll") for (int m = 0; m < 4; ++m) _Pragma("unroll") for (int k = 0; k < 2; ++k) dst[m][k] = *(const PG8_LAS bf16x8*)(lds + PG8_SA(b, h) + aoff + m * 2048 + k * 1024); } while (0)
#define PG8_LDB(dst, b, h) do { _Pragma("unroll") for (int n = 0; n < 2; ++n) _Pragma("unroll") for (int k = 0; k < 2; ++k) dst[n][k] = *(const PG8_LAS bf16x8*)(lds + PG8_SB(b, h) + boff + n * 2048 + k * 1024); } while (0)
#define PG8_MMA(ai, bj, At, Bt) do { __builtin_amdgcn_s_setprio(1); _Pragma("unroll") for (int m = 0; m < 4; ++m) _Pragma("unroll") for (int n = 0; n < 2; ++n) _Pragma("unroll") for (int k = 0; k < 2; ++k) \
        acc[ai][bj][m][n] = __builtin_amdgcn_mfma_f32_16x16x32_bf16(Bt[n][k], At[m][k], acc[ai][bj][m][n], 0, 0, 0); __builtin_amdgcn_s_setprio(0); } while (0)
#define PG8_WAIT_V(n) asm volatile("s_waitcnt vmcnt(" #n ")" ::: "memory")
#define PG8_WAIT_L(n) asm volatile("s_waitcnt lgkmcnt(" #n ")" ::: "memory")
#define PG8_BAR __builtin_amdgcn_s_barrier()
#define PG8_SCHED __builtin_amdgcn_sched_barrier(0)
    Unit cur, nxt; int ui = 0;
    if (!S.next(0, cur)) return;
    f32x4 acc[2][2][4][2];
#pragma unroll
    for (int a = 0; a < 2; ++a)
#pragma unroll
        for (int b = 0; b < 2; ++b)
#pragma unroll
            for (int m = 0; m < 4; ++m)
#pragma unroll
                for (int n = 0; n < 2; ++n) acc[a][b][m][n] = (f32x4){0.f, 0.f, 0.f, 0.f};
    bf16x8 At[4][2], B0[2][2], B1[2][2];
    const char* cA = (const char*)g.A + (size_t)cur.pm * tstep; const char* cB = (const char*)g.Bt + (size_t)cur.pn * tstep;
    S.a_ready(cur);
    if constexpr (SP2) {
        PG8_STAGE(PG8_SB(0, 0), cB, voffB); PG8_STAGE(PG8_SB(0, 1), cB + hstep, voffB); PG8_STAGE(PG8_SA(0, 0), cA, voffA); PG8_STAGE(PG8_SA(0, 1), cA + hstep, voffA);
        if (wr == 1) PG8_BAR;
        PG8_WAIT_V(2); PG8_BAR;
        PG8_STAGE(PG8_SB(1, 0), cB + kstep, voffB); PG8_STAGE(PG8_SA(1, 0), cA + kstep, voffA); PG8_STAGE(PG8_SB(1, 1), cB + hstep + kstep, voffB);
        PG8_WAIT_V(6); PG8_BAR;
    } else {
        PG8_STAGE(PG8_SB(0, 0), cB, voffB); PG8_STAGE(PG8_SA(0, 0), cA, voffA); PG8_STAGE(PG8_SB(0, 1), cB + hstep, voffB); PG8_STAGE(PG8_SA(0, 1), cA + hstep, voffA);
        if (wr == 1) PG8_BAR;
        PG8_WAIT_V(4); PG8_BAR;
        PG8_STAGE(PG8_SB(1, 0), cB + kstep, voffB); PG8_STAGE(PG8_SA(1, 0), cA + kstep, voffA); PG8_STAGE(PG8_SB(1, 1), cB + hstep + kstep, voffB);
        PG8_WAIT_V(6); PG8_BAR;
    }
    for (;;) {
        const bool has_next = S.next(ui + 1, nxt);
        const char* nA = has_next ? (const char*)g.A + (size_t)nxt.pm * tstep : cA; const char* nB = has_next ? (const char*)g.Bt + (size_t)nxt.pn * tstep : cB;
        for (int t = 0; t < nt; t += 2) {
            const bool last = (t == nt - 2);
            const char* a1 = cA + (size_t)(t + 1) * kstep;
            const char* a2 = last ? nA : cA + (size_t)(t + 2) * kstep; const char* b2 = last ? nB : cB + (size_t)(t + 2) * kstep;
            const char* a3 = a2 + kstep; const char* b3 = b2 + kstep;
            if (last && has_next) S.a_ready(nxt);
            if constexpr (SP2) {
            PG8_LDB(B0, 0, 0); PG8_LDB(B1, 0, 1); PG8_SCHED; PG8_LDA(At, 0, 0); PG8_STAGE(PG8_SA(1, 1), a1 + hstep, voffA);
            PG8_WAIT_V(8); PG8_WAIT_L(0); PG8_BAR; PG8_MMA(0, 0, At, B0); PG8_MMA(0, 1, At, B1); PG8_BAR; PG8_SCHED;
            PG8_LDA(At, 0, 1); PG8_STAGE(PG8_SB(0, 0), b2, voffB); PG8_STAGE(PG8_SB(0, 1), b2 + hstep, voffB); PG8_STAGE(PG8_SA(0, 0), a2, voffA);
            PG8_WAIT_V(8); PG8_WAIT_L(0); PG8_BAR; PG8_MMA(1, 0, At, B0); PG8_MMA(1, 1, At, B1); PG8_BAR; PG8_SCHED;
            PG8_LDB(B0, 1, 0); PG8_LDB(B1, 1, 1); PG8_SCHED; PG8_LDA(At, 1, 0); PG8_STAGE(PG8_SA(0, 1), a2 + hstep, voffA);
            PG8_WAIT_V(8); PG8_WAIT_L(0); PG8_BAR; PG8_MMA(0, 0, At, B0); PG8_MMA(0, 1, At, B1); PG8_BAR; PG8_SCHED;
            PG8_LDA(At, 1, 1); PG8_STAGE(PG8_SB(1, 0), b3, voffB); PG8_STAGE(PG8_SB(1, 1), b3 + hstep, voffB); PG8_STAGE(PG8_SA(1, 0), a3, voffA);
            PG8_WAIT_V(8); PG8_WAIT_L(0); PG8_BAR; PG8_MMA(1, 0, At, B0); PG8_MMA(1, 1, At, B1); PG8_BAR; PG8_SCHED;
            } else {
            PG8_LDB(B0, 0, 0); PG8_SCHED; PG8_LDA(At, 0, 0); PG8_STAGE(PG8_SA(1, 1), a1 + hstep, voffA);
            PG8_WAIT_L(8); PG8_BAR; PG8_WAIT_L(0); PG8_MMA(0, 0, At, B0); PG8_BAR; PG8_SCHED;
            PG8_LDB(B1, 0, 1); PG8_STAGE(PG8_SB(0, 0), b2, voffB);
            PG8_BAR; PG8_WAIT_L(0); PG8_MMA(0, 1, At, B1); PG8_BAR;
            PG8_LDA(At, 0, 1); PG8_STAGE(PG8_SA(0, 0), a2, voffA);
            PG8_BAR; PG8_WAIT_L(0); PG8_MMA(1, 0, At, B0); PG8_BAR; PG8_SCHED;
            PG8_STAGE(PG8_SB(0, 1), b2 + hstep, voffB);
            PG8_WAIT_V(6); PG8_BAR; PG8_MMA(1, 1, At, B1); PG8_BAR;
            PG8_LDB(B0, 1, 0); PG8_SCHED; PG8_LDA(At, 1, 0); PG8_STAGE(PG8_SA(0, 1), a2 + hstep, voffA);
            PG8_WAIT_L(8); PG8_BAR; PG8_WAIT_L(0); PG8_MMA(0, 0, At, B0); PG8_BAR; PG8_SCHED;
            PG8_LDB(B1, 1, 1); PG8_STAGE(PG8_SB(1, 0), b3, voffB);
            PG8_BAR; PG8_WAIT_L(0); PG8_MMA(0, 1, At, B1); PG8_BAR;
            PG8_LDA(At, 1, 1); PG8_STAGE(PG8_SA(1, 0), a3, voffA);
            PG8_BAR; PG8_WAIT_L(0); PG8_MMA(1, 0, At, B0); PG8_BAR; PG8_SCHED;
            PG8_STAGE(PG8_SB(1, 1), b3 + hstep, voffB);
            PG8_WAIT_V(6); PG8_BAR; PG8_MMA(1, 1, At, B1); PG8_BAR;
            }
        }
        if constexpr (ALIGN_EPI) { if (wr == 0) PG8_BAR; }
        if constexpr (!Epi::AFTER_DRAIN) { E(acc, cur, wr, wc, fr, fq); S.done(cur); }
        if (!has_next) break;
#pragma unroll
        for (int a = 0; a < 2; ++a)
#pragma unroll
            for (int b = 0; b < 2; ++b)
#pragma unroll
                for (int m = 0; m < 4; ++m)
#pragma unroll
                    for (int n = 0; n < 2; ++n) acc[a][b][m][n] = (f32x4){0.f, 0.f, 0.f, 0.f};
        cur = nxt; cA = nA; cB = nB; ++ui;
        if constexpr (ALIGN_EPI) { if (wr == 1) PG8_BAR; }
    }
    PG8_WAIT_V(0);
    if constexpr (!ALIGN_EPI) { if (wr == 0) PG8_BAR; }
    PG8_BAR;
    if constexpr (Epi::AFTER_DRAIN) { E.fused(acc, cur, wr, wc, fr, fq, lds, wid, lane); S.done(cur); }
#undef PG8_SA
#undef PG8_SB
#undef PG8_STAGE
#undef PG8_LDA
#undef PG8_LDB
#undef PG8_MMA
#undef PG8_WAIT_V
#undef PG8_WAIT_L
#undef PG8_BAR
#undef PG8_SCHED
}
}

constexpr int NB = 4, SEQ = 8192, DM = 2048, MTOK = NB * SEQ, INC = 4608, DFF = 5632, NMODC = 6 * DM;
constexpr int NWAVES = 8, NTHR = 512;
constexpr float EPS = 1e-6f, LOG2E = 1.44269504088896f;
constexpr int O_QA = 0, O_KA = 1024, O_VA = 1280, O_QD = 1536, O_KD = 2560, O_VD = 3584;
constexpr size_t WS_MOD = 0;
constexpr size_t WS_WIN = 1u << 20;
constexpr size_t WS_WO = WS_WIN + (size_t)INC * DM * 2;
constexpr size_t WS_WGU = WS_WO + (size_t)DM * DM * 2;
constexpr size_t WS_WD = WS_WGU + (size_t)2 * DFF * DM * 2;
constexpr size_t WS_H = WS_WD + (size_t)DM * DFF * 2;
constexpr size_t WS_CAT = WS_H + (size_t)MTOK * DM * 2;
constexpr size_t WS_PROJ = WS_CAT + (size_t)MTOK * DM * 2;
constexpr size_t WS_VT = WS_PROJ + (size_t)MTOK * INC * 2;
constexpr size_t WS_KVB = WS_VT + (size_t)NB * 2 * 128 * SEQ * 2;
constexpr size_t WS_END = WS_KVB + (size_t)NB * 8 * 128 * 32768;
constexpr size_t WS_FF = WS_PROJ;
static_assert(WS_FF + (size_t)MTOK * DFF * 2 <= WS_END, "ff overlay");
constexpr int LDS_BYTES = 163840;

#define LAS __attribute__((address_space(3)))
typedef unsigned short bf16;
typedef unsigned v4u __attribute__((ext_vector_type(4)));
typedef unsigned v2u __attribute__((ext_vector_type(2)));
typedef float f32x4 __attribute__((ext_vector_type(4)));
typedef float f32x16 __attribute__((ext_vector_type(16)));
typedef short bf16x8 __attribute__((ext_vector_type(8)));
#define MFMA32(a, b, c) __builtin_amdgcn_mfma_f32_32x32x16_bf16((a), (b), (c), 0, 0, 0)
using pg8::cvtpk;

__device__ __forceinline__ float wave_sum(float v) {
#pragma unroll
    for (int o = 1; o < 64; o <<= 1) v += __shfl_xor(v, o);
    return v;
}
__device__ __forceinline__ float bf_lo(unsigned w) { return __uint_as_float(w << 16); }
__device__ __forceinline__ float bf_hi(unsigned w) { return __uint_as_float(w & 0xffff0000u); }

struct Args {
    const float *x, *c, *w_ada, *b_ada, *g1n, *w_in, *a_sink, *a_gain, *lq1, *lk1, *lq2, *lk2, *subg, *w_o, *g2n, *w_gate, *w_up, *w_down, *gfin;
    float* out; unsigned char* ws;
};

template <int MODE>
__device__ __forceinline__ void transpose_item(const float* W, int K, int N, bf16* WT, const float* ga, const float* gb, LAS float* scr, int item, int lane) {
    const int nblk = N / 32, kb = item / nblk, nb = item % nblk, k0 = 64 * kb, n0 = 32 * nb;
#pragma unroll 8
    for (int i = 0; i < 32; ++i) { const int kk = 2 * i + (lane >> 5); float v = W[(size_t)(k0 + kk) * N + n0 + (lane & 31)];
        if (MODE == 3) { const int k = k0 + kk; v *= (k < 1024) ? ga[k] : gb[(k - 1024) & 127] * 0.8f; }
        scr[kk * 33 + (lane & 31)] = v; }
    asm volatile("s_waitcnt lgkmcnt(0)" ::: "memory");
    const int c = lane & 7;
#pragma unroll
    for (int j = 0; j < 4; ++j) { const int n = (lane >> 3) + 8 * j; const LAS float* s = scr + (8 * c) * 33 + n;
        v4u o; o.x = cvtpk(s[0 * 33], s[1 * 33]); o.y = cvtpk(s[2 * 33], s[3 * 33]); o.z = cvtpk(s[4 * 33], s[5 * 33]); o.w = cvtpk(s[6 * 33], s[7 * 33]);
        const int ng = n0 + n; int dr = ng;
        if (MODE == 1) dr = (ng >> 7) * 256 + (ng & 127);
        if (MODE == 2) dr = (ng >> 7) * 256 + 128 + (ng & 127);
        *(v4u*)(WT + (size_t)dr * K + k0 + 8 * c) = o; }
    asm volatile("s_waitcnt lgkmcnt(0)" ::: "memory");
}
__device__ __forceinline__ void ada_item(const float* c, const float* w_ada, float* mod, int item, int lane) {
    const int cch = item % 48, dch = item / 48, col0 = cch * 256 + 4 * lane, d0 = dch * 64;
    float sl[4];
#pragma unroll
    for (int b = 0; b < 4; ++b) { const float cv = c[b * DM + d0 + lane]; sl[b] = cv / (1.0f + __expf(-cv)); }
    f32x4 acc[4];
#pragma unroll
    for (int b = 0; b < 4; ++b) acc[b] = (f32x4){0.f, 0.f, 0.f, 0.f};
    for (int k8 = 0; k8 < 8; ++k8) {
#pragma unroll
        for (int j = 0; j < 8; ++j) { const int kk = k8 * 8 + j;
            const f32x4 w = *(const f32x4*)(w_ada + (size_t)(d0 + kk) * NMODC + col0);
#pragma unroll
            for (int b = 0; b < 4; ++b) { const float s = __uint_as_float(__builtin_amdgcn_readlane(__float_as_uint(sl[b]), kk)); acc[b] += w * s; } }
    }
#pragma unroll
    for (int b = 0; b < 4; ++b)
#pragma unroll
        for (int e = 0; e < 4; ++e) __hip_atomic_fetch_add(mod + (size_t)b * NMODC + col0 + e, acc[b][e], __ATOMIC_RELAXED, __HIP_MEMORY_SCOPE_AGENT);
}
__device__ __forceinline__ void norm_mod_phase(const float* X, bf16* H, const float* gain, const float* mod, const float* b_ada, int sh_off, int sc_off, int gw, int ngw, int lane) {
    for (int chunk = gw; chunk < MTOK / 16; chunk += ngw) {
        const int row0 = chunk * 16, b = row0 / SEQ;
        f32x4 A[8], Bv[8];
#pragma unroll
        for (int j = 0; j < 8; ++j) { const int col = 4 * lane + 256 * j;
            const f32x4 g = *(const f32x4*)(gain + col);
            const f32x4 sc = *(const f32x4*)(mod + (size_t)b * NMODC + sc_off + col) + *(const f32x4*)(b_ada + sc_off + col);
            Bv[j] = *(const f32x4*)(mod + (size_t)b * NMODC + sh_off + col) + *(const f32x4*)(b_ada + sh_off + col);
            A[j] = g * (sc + 1.0f); }
        for (int r = 0; r < 16; r += 2) {
            const f32x4* xr0 = (const f32x4*)(X + (size_t)(row0 + r) * DM) + lane;
            const f32x4* xr1 = xr0 + DM / 4;
            f32x4 v0[8], v1[8]; float s0 = 0.f, s1 = 0.f;
#pragma unroll
            for (int j = 0; j < 8; ++j) { v0[j] = xr0[64 * j]; v1[j] = xr1[64 * j]; }
#pragma unroll
            for (int j = 0; j < 8; ++j) { s0 += (v0[j].x * v0[j].x + v0[j].y * v0[j].y) + (v0[j].z * v0[j].z + v0[j].w * v0[j].w); s1 += (v1[j].x * v1[j].x + v1[j].y * v1[j].y) + (v1[j].z * v1[j].z + v1[j].w * v1[j].w); }
            const float rstd0 = 1.0f / sqrtf(wave_sum(s0) * (1.0f / DM) + EPS), rstd1 = 1.0f / sqrtf(wave_sum(s1) * (1.0f / DM) + EPS);
            v2u* o0 = (v2u*)(H + (size_t)(row0 + r) * DM) + lane; v2u* o1 = o0 + DM / 4;
#pragma unroll
            for (int j = 0; j < 8; ++j) { const f32x4 y0 = v0[j] * rstd0 * A[j] + Bv[j], y1 = v1[j] * rstd1 * A[j] + Bv[j];
                v2u w; w.x = cvtpk(y0.x, y0.y); w.y = cvtpk(y0.z, y0.w); o0[64 * j] = w; w.x = cvtpk(y1.x, y1.y); w.y = cvtpk(y1.z, y1.w); o1[64 * j] = w; }
        }
    }
}
__device__ __forceinline__ void final_norm_phase(float* X, const float* gain, int gw, int ngw, int lane) {
    f32x4 G[8];
#pragma unroll
    for (int j = 0; j < 8; ++j) G[j] = *(const f32x4*)(gain + 4 * lane + 256 * j);
    for (int row = gw; row < MTOK; row += 2 * ngw) {
        const int row1 = row + ngw; const bool has1 = row1 < MTOK;
        f32x4* xr0 = (f32x4*)(X + (size_t)row * DM) + lane; f32x4* xr1 = (f32x4*)(X + (size_t)(has1 ? row1 : row) * DM) + lane;
        f32x4 v0[8], v1[8]; float s0 = 0.f, s1 = 0.f;
#pragma unroll
        for (int j = 0; j < 8; ++j) { v0[j] = xr0[64 * j]; v1[j] = xr1[64 * j]; }
#pragma unroll
        for (int j = 0; j < 8; ++j) { s0 += (v0[j].x * v0[j].x + v0[j].y * v0[j].y) + (v0[j].z * v0[j].z + v0[j].w * v0[j].w); s1 += (v1[j].x * v1[j].x + v1[j].y * v1[j].y) + (v1[j].z * v1[j].z + v1[j].w * v1[j].w); }
        const float rstd0 = 1.0f / sqrtf(wave_sum(s0) * (1.0f / DM) + EPS), rstd1 = 1.0f / sqrtf(wave_sum(s1) * (1.0f / DM) + EPS);
#pragma unroll
        for (int j = 0; j < 8; ++j) xr0[64 * j] = v0[j] * rstd0 * G[j];
        if (has1) {
#pragma unroll
            for (int j = 0; j < 8; ++j) xr1[64 * j] = v1[j] * rstd1 * G[j]; }
    }
}
__device__ __forceinline__ void vt_item(const bf16* proj, bf16* VtA, unsigned char* KVB, LAS unsigned short* T, int item, int lane) {
    const int tb = item & 127, dh = (item >> 7) & 1, rest = item >> 8, vh = rest % 10, b = rest / 10;
    const int colbase = (vh < 2 ? O_VA + vh * 128 : O_VD + (vh - 2) * 128) + dh * 64, t0 = tb * 64;
#pragma unroll
    for (int i = 0; i < 8; ++i) { const int row = 8 * i + (lane >> 3), ch = lane & 7;
        const v4u v = *(const v4u*)(proj + (size_t)(b * SEQ + t0 + row) * INC + colbase + ch * 8);
        const unsigned w[4] = {v.x, v.y, v.z, v.w};
#pragma unroll
        for (int j = 0; j < 4; ++j) { T[(ch * 8 + 2 * j) * 66 + row] = (unsigned short)(w[j] & 0xffffu); T[(ch * 8 + 2 * j + 1) * 66 + row] = (unsigned short)(w[j] >> 16); } }
    asm volatile("s_waitcnt lgkmcnt(0)" ::: "memory");
#pragma unroll
    for (int i = 0; i < 8; ++i) { const int cc = 8 * i + (lane >> 3), q = lane & 7;
        const LAS unsigned* s = (const LAS unsigned*)(T + cc * 66 + q * 8);
        v4u o; o.x = s[0]; o.y = s[1]; o.z = s[2]; o.w = s[3];
        const int d = dh * 64 + cc;
        if (vh < 2) *(v4u*)(VtA + ((size_t)((b * 2 + vh) * 128 + d)) * SEQ + t0 + q * 8) = o;
        else *(v4u*)(KVB + ((size_t)((b * 8 + vh - 2) * 128 + tb)) * 32768 + 16384 + d * 128 + ((q ^ ((d >> 1) & 7)) << 4)) = o; }
    asm volatile("s_waitcnt lgkmcnt(0)" ::: "memory");
}

template <int DQK, int MODE>
__device__ __forceinline__ void attn_tile(const LAS unsigned char* Kt, const LAS unsigned char* Vtl, const bf16x8 (&qf)[DQK / 16], f32x16 (&O)[4], float& m, float& l,
                                          int qpos, int key0, float c1, float slope2, int lane) {
    constexpr int KROW = DQK * 2 + 16;
    const int r = lane & 31, hi = lane >> 5;
    const int kr = (r & 0x13) | ((r & 4) << 1) | ((r & 8) >> 1);
    f32x16 S0, S1;
#pragma unroll
    for (int t = 0; t < 16; ++t) { S0[t] = 0.f; S1[t] = 0.f; }
#pragma unroll
    for (int s = 0; s < DQK / 16; ++s) {
        const bf16x8 k0 = *(const LAS bf16x8*)(Kt + kr * KROW + s * 32 + hi * 16);
        const bf16x8 k1 = *(const LAS bf16x8*)(Kt + (32 + kr) * KROW + s * 32 + hi * 16);
        S0 = MFMA32(k0, qf[s], S0); S1 = MFMA32(k1, qf[s], S1);
    }
    float mx = -1e30f;
    const int dq = qpos - key0 - 8 * hi;
#pragma unroll
    for (int t = 0; t < 16; ++t) {
        const int d0 = dq - ((t & 7) + 16 * (t >> 3)), d1 = d0 - 32;
        const int a0 = d0 < 0 ? -d0 : d0, a1 = d1 < 0 ? -d1 : d1;
        float v0 = S0[t] - slope2 * (float)a0, v1 = S1[t] - slope2 * (float)a1;
        if (MODE == 1) { v0 = (a0 <= 128) ? v0 : -1e30f; v1 = (a1 <= 128) ? v1 : -1e30f; }
        S0[t] = v0; S1[t] = v1; mx = fmaxf(mx, fmaxf(v0, v1));
    }
    mx = fmaxf(mx, __shfl_xor(mx, 32));
    const float mnew = fmaxf(m, mx);
    if (__builtin_amdgcn_ballot_w64(mnew > m) != 0ull) {
        const float alpha = __builtin_amdgcn_exp2f(m - mnew);
        l *= alpha;
#pragma unroll
        for (int db = 0; db < 4; ++db) O[db] = O[db] * alpha;
    }
    m = mnew;
    float ps = 0.f;
#pragma unroll
    for (int t = 0; t < 16; ++t) { const float p0 = __builtin_amdgcn_exp2f(S0[t] - mnew), p1 = __builtin_amdgcn_exp2f(S1[t] - mnew); S0[t] = p0; S1[t] = p1; ps += p0 + p1; }
    l += ps;
    bf16x8 pf[4];
    { v4u w;
      w.x = cvtpk(S0[0], S0[1]); w.y = cvtpk(S0[2], S0[3]); w.z = cvtpk(S0[4], S0[5]); w.w = cvtpk(S0[6], S0[7]); pf[0] = __builtin_bit_cast(bf16x8, w);
      w.x = cvtpk(S0[8], S0[9]); w.y = cvtpk(S0[10], S0[11]); w.z = cvtpk(S0[12], S0[13]); w.w = cvtpk(S0[14], S0[15]); pf[1] = __builtin_bit_cast(bf16x8, w);
      w.x = cvtpk(S1[0], S1[1]); w.y = cvtpk(S1[2], S1[3]); w.z = cvtpk(S1[4], S1[5]); w.w = cvtpk(S1[6], S1[7]); pf[2] = __builtin_bit_cast(bf16x8, w);
      w.x = cvtpk(S1[8], S1[9]); w.y = cvtpk(S1[10], S1[11]); w.z = cvtpk(S1[12], S1[13]); w.w = cvtpk(S1[14], S1[15]); pf[3] = __builtin_bit_cast(bf16x8, w); }
#pragma unroll
    for (int db = 0; db < 4; ++db)
#pragma unroll
        for (int s4 = 0; s4 < 4; ++s4) {
            const bf16x8 vf = *(const LAS bf16x8*)(Vtl + (32 * db + r) * 144 + s4 * 32 + hi * 16);
            O[db] = MFMA32(vf, pf[s4], O[db]);
        }
}

__device__ __forceinline__ float xhalf_max(float x) { auto rr = __builtin_amdgcn_permlane32_swap(__float_as_uint(x), __float_as_uint(x), false, false); return fmaxf(__uint_as_float(rr[0]), __uint_as_float(rr[1])); }
__device__ __forceinline__ float xhalf_sum(float x) { auto rr = __builtin_amdgcn_permlane32_swap(__float_as_uint(x), __float_as_uint(x), false, false); return __uint_as_float(rr[0]) + __uint_as_float(rr[1]); }
constexpr int B_KB = 65536, B_VB = 0;
__device__ __forceinline__ void b_qk(const LAS unsigned char* Kt, const LAS unsigned char* Qw, const int (&kaddr)[4], const f32x16& ci, f32x16& S0, f32x16& S1) {
    bf16x8 kf[4], qf[4];
#pragma unroll
    for (int s = 0; s < 4; ++s) { kf[s] = *(const LAS bf16x8*)(Kt + kaddr[s]); qf[s] = *(const LAS bf16x8*)(Qw + s * 1024); }
    S0 = MFMA32(kf[0], qf[0], ci);
#pragma unroll
    for (int s = 1; s < 4; ++s) S0 = MFMA32(kf[s], qf[s], S0);
#pragma unroll
    for (int s = 0; s < 4; ++s) kf[s] = *(const LAS bf16x8*)(Kt + kaddr[s] + 4096);
    S1 = MFMA32(kf[0], qf[0], ci);
#pragma unroll
    for (int s = 1; s < 4; ++s) S1 = MFMA32(kf[s], qf[s], S1);
}
constexpr int B_QB = 131072;
#define B_WAITV(n) asm volatile("s_waitcnt vmcnt(" #n ")" ::: "memory")
#define B_BAR() do { asm volatile("s_waitcnt lgkmcnt(0)" ::: "memory"); __builtin_amdgcn_s_barrier(); asm volatile("" ::: "memory"); } while (0)
#define B_SCHED() __builtin_amdgcn_sched_barrier(0)
__device__ __forceinline__ void mfma_acc(f32x16& acc, const bf16x8& a, const bf16x8& b) { asm volatile("v_mfma_f32_32x32x16_bf16 %0, %1, %2, %0" : "+v"(acc) : "v"(a), "v"(b)); }
__device__ __forceinline__ void mfma_ini(f32x16& d, const bf16x8& a, const bf16x8& b, const f32x16& c) { asm volatile("v_mfma_f32_32x32x16_bf16 %0, %1, %2, %3" : "=&v"(d) : "v"(a), "v"(b), "v"(c)); }
__device__ __forceinline__ void exp_slice(float& p0, float& p1, float& ps, float a0, float a1, float m0, float m1) {
    asm volatile("v_sub_f32 %0, %3, %5\n\tv_sub_f32 %1, %4, %6\n\tv_exp_f32 %0, %0\n\tv_exp_f32 %1, %1\n\tv_add_f32 %2, %2, %0\n\tv_add_f32 %2, %2, %1" : "=&v"(p0), "=&v"(p1), "+v"(ps) : "v"(a0), "v"(a1), "v"(m0), "v"(m1)); }
template <int T4>
__device__ __forceinline__ void b_fstep(LAS unsigned char* lds, int t, int td, int c, int wave, const unsigned char* tile0, unsigned loff,
                                        const int (&kaddr)[4], const int (&vaddr)[4], const LAS unsigned char* Qw, f32x16& bvs, f32x16& A0, f32x16& A1, f32x16 (&O)[4], bf16x8 (&pp)[4],
                                        float& m, float& l, int qpos, int hi, float slope2) {
    constexpr int NT = SEQ / 64;
    { const int tk = (t + 3 < NT) ? t + 3 : NT - 1, tv = (t + 2 < NT) ? t + 2 : NT - 1;
      const unsigned char* kb = tile0 + (size_t)tk * 32768 + loff; const unsigned char* vb = tile0 + (size_t)tv * 32768 + 16384 + loff;
      __builtin_amdgcn_global_load_lds((const unsigned*)(kb), (LAS unsigned*)(lds + B_KB + ((T4 + 3) & 3) * 16384 + wave * 2048), 16, 0, 0);
      __builtin_amdgcn_global_load_lds((const unsigned*)(kb + 1024), (LAS unsigned*)(lds + B_KB + ((T4 + 3) & 3) * 16384 + wave * 2048 + 1024), 16, 0, 0);
      __builtin_amdgcn_global_load_lds((const unsigned*)(vb), (LAS unsigned*)(lds + B_VB + ((T4 + 2) & 3) * 16384 + wave * 2048), 16, 0, 0);
      __builtin_amdgcn_global_load_lds((const unsigned*)(vb + 1024), (LAS unsigned*)(lds + B_VB + ((T4 + 2) & 3) * 16384 + wave * 2048 + 1024), 16, 0, 0); }
    const int key0 = t * 64;
    float base, e1;
    if (t == td) {
        const int dq = qpos - key0 - 8 * hi;
#pragma unroll
        for (int r = 0; r < 16; ++r) { const int d0 = dq - ((r & 7) + 16 * (r >> 3)), d1 = d0 - 32;
            const int a0 = d0 < 0 ? -d0 : d0, a1 = d1 < 0 ? -d1 : d1;
            A0[r] = A0[r] - bvs[r] - slope2 * (float)a0; A1[r] = A1[r] - bvs[r] - slope2 * (float)a1; }
        bvs = -bvs; base = 0.f; e1 = 0.f;
    } else { const float sg = (t < td) ? slope2 : -slope2; base = sg * (float)(key0 + 8 * hi - qpos); e1 = sg * 32.0f; }
    B_SCHED();
    const LAS unsigned char* Vb = lds + B_VB + ((T4 + 3) & 3) * 16384;
    const LAS unsigned char* Kt = lds + ((T4 + 1) & 3) * 16384;
    f32x16 N0, N1;
    bf16x8 fa[4], fb[4], qf[4];
    float mx0 = -1e30f, mx1 = -1e30f, mnew = m, alpha = 1.0f, mr0 = 0.f, mr1 = 0.f, ps = 0.f;
    v4u w0, w1;
#pragma unroll
    for (int s4 = 0; s4 < 4; ++s4) fa[s4] = *(const LAS bf16x8*)(Vb + vaddr[s4]);
    B_SCHED();
#pragma unroll
    for (int i = 0; i < 24; ++i) {
        const int g = i >> 2, j = i & 3;
        if (j == 0) {
            if (g == 0) {
#pragma unroll
                for (int s4 = 0; s4 < 4; ++s4) fb[s4] = *(const LAS bf16x8*)(Vb + vaddr[s4] + 4096); }
            if (g == 1) {
#pragma unroll
                for (int s4 = 0; s4 < 4; ++s4) fa[s4] = *(const LAS bf16x8*)(Vb + vaddr[s4] + 8192); }
            if (g == 2) {
#pragma unroll
                for (int s4 = 0; s4 < 4; ++s4) fb[s4] = *(const LAS bf16x8*)(Vb + vaddr[s4] + 12288); }
            if (g == 3) {
#pragma unroll
                for (int s4 = 0; s4 < 4; ++s4) { fa[s4] = *(const LAS bf16x8*)(Kt + kaddr[s4]); qf[s4] = *(const LAS bf16x8*)(Qw + s4 * 1024); } }
            if (g == 4) {
#pragma unroll
                for (int s4 = 0; s4 < 4; ++s4) fb[s4] = *(const LAS bf16x8*)(Kt + kaddr[s4] + 4096); }
        }
        if (g == 0) mfma_acc(O[0], fa[j], pp[j]);
        if (g == 1) mfma_acc(O[1], fb[j], pp[j]);
        if (g == 2) mfma_acc(O[2], fa[j], pp[j]);
        if (g == 3) mfma_acc(O[3], fb[j], pp[j]);
        if (g == 4) { if (j == 0) N0 = MFMA32(fa[0], qf[0], bvs); else mfma_acc(N0, fa[j], qf[j]); }
        if (g == 5) { if (j == 0) N1 = MFMA32(fb[0], qf[0], bvs); else mfma_acc(N1, fb[j], qf[j]); }
        if (i < 4) {
#pragma unroll
            for (int r = 4 * i; r < 4 * i + 4; ++r) { mx0 = fmaxf(mx0, A0[r]); mx1 = fmaxf(mx1, A1[r]); } }
        if (i == 4) { const float mx = xhalf_max(fmaxf(mx0, mx1 + e1) + base); mnew = fmaxf(m, mx); alpha = __builtin_amdgcn_exp2f(m - mnew); mr0 = mnew - base; mr1 = mr0 - e1; }
        if (i >= 5 && i < 13) { const int r = 2 * (i - 5); float x0, x1; exp_slice(x0, x1, ps, A0[r], A0[r + 1], mr0, mr0); A0[r] = x0; A0[r + 1] = x1; }
        if (i == 13) { w0.x = cvtpk(A0[0], A0[1]); w0.y = cvtpk(A0[2], A0[3]); w0.z = cvtpk(A0[4], A0[5]); w0.w = cvtpk(A0[6], A0[7]);
                       w1.x = cvtpk(A0[8], A0[9]); w1.y = cvtpk(A0[10], A0[11]); w1.z = cvtpk(A0[12], A0[13]); w1.w = cvtpk(A0[14], A0[15]); }
        if (i >= 13 && i < 21) { const int r = 2 * (i - 13); float x0, x1; exp_slice(x0, x1, ps, A1[r], A1[r + 1], mr1, mr1); A1[r] = x0; A1[r + 1] = x1; }
        if (i == 21) { v4u w2, w3; w2.x = cvtpk(A1[0], A1[1]); w2.y = cvtpk(A1[2], A1[3]); w2.z = cvtpk(A1[4], A1[5]); w2.w = cvtpk(A1[6], A1[7]); pp[2] = __builtin_bit_cast(bf16x8, w2);
                       w3.x = cvtpk(A1[8], A1[9]); w3.y = cvtpk(A1[10], A1[11]); w3.z = cvtpk(A1[12], A1[13]); w3.w = cvtpk(A1[14], A1[15]); pp[3] = __builtin_bit_cast(bf16x8, w3); }
        if (i == 22) { pp[0] = __builtin_bit_cast(bf16x8, w0); pp[1] = __builtin_bit_cast(bf16x8, w1); }
        B_SCHED();
    }
    asm volatile("s_nop 15");
    if (__builtin_amdgcn_ballot_w64(mnew > m) != 0ull) {
#pragma unroll
        for (int db = 0; db < 4; ++db) O[db] = O[db] * alpha;
    }
    l = l * alpha + ps; m = mnew;
    A0 = N0; A1 = N1;
    B_WAITV(6); B_BAR();
}
__device__ __forceinline__ void attn_unit_B(LAS unsigned char* lds, const bf16* proj, const unsigned char* KVB, bf16* cat, int b, int h, int qb, float lam, int tid, int wave, int lane) {
    asm volatile("" : "+v"(lane));
    const int c = wave >> 2, sb = wave & 3, r = lane & 31, hi = lane >> 5;
    const int q0 = qb * 128 + sb * 32, qpos = q0 + r, td = q0 >> 6;
    const size_t rowbase = (size_t)b * SEQ;
    LAS unsigned char* Qw = lds + B_QB + wave * 4096 + lane * 16;
#pragma unroll
    for (int s = 0; s < 4; ++s) *(LAS bf16x8*)(Qw + s * 1024) = *(const bf16x8*)(proj + (rowbase + qpos) * INC + O_QD + h * 128 + c * 64 + 16 * s + 8 * hi);
    { const v4u z = {0u, 0u, 0u, 0u}; *(LAS v4u*)(lds + B_VB + 3 * 16384 + tid * 32) = z; *(LAS v4u*)(lds + B_VB + 3 * 16384 + tid * 32 + 16) = z; }
    f32x16 O[4];
#pragma unroll
    for (int db = 0; db < 4; ++db)
#pragma unroll
        for (int t = 0; t < 16; ++t) O[db][t] = 0.f;
    float m = -1e30f, l = 0.f;
    const float slope2 = __builtin_amdgcn_exp2f(-0.5f * (float)(9 + h)) * LOG2E;
    f32x16 bvs;
#pragma unroll
    for (int t = 0; t < 16; ++t) bvs[t] = slope2 * (float)((t & 7) + 16 * (t >> 3));
    const int kr = (r & 0x13) | ((r & 4) << 1) | ((r & 8) >> 1), kk = (kr >> 1) & 7, vk = (r >> 1) & 7;
    int kaddr[4], vaddr[4];
#pragma unroll
    for (int s = 0; s < 4; ++s) { kaddr[s] = B_KB + c * 8192 + kr * 128 + (((2 * s + hi) ^ kk) << 4); vaddr[s] = r * 128 + (((2 * s + hi) ^ vk) << 4); }
    const unsigned char* tile0 = KVB + ((size_t)((b * 8 + h) * 128)) * 32768;
    const unsigned loff = (unsigned)(wave * 2048 + lane * 16);
    const unsigned char* ks0 = tile0 + loff;
    const unsigned char* ks1 = ks0 + 1024;
    const unsigned char* vs0 = ks0 + 16384;
    const unsigned char* vs1 = vs0 + 1024;
#pragma unroll
    for (int i = 0; i < 3; ++i) {
        __builtin_amdgcn_global_load_lds((const unsigned*)(ks0 + i * 32768), (LAS unsigned*)(lds + B_KB + i * 16384 + wave * 2048), 16, 0, 0);
        __builtin_amdgcn_global_load_lds((const unsigned*)(ks1 + i * 32768), (LAS unsigned*)(lds + B_KB + i * 16384 + wave * 2048 + 1024), 16, 0, 0);
        if (i < 2) {
        __builtin_amdgcn_global_load_lds((const unsigned*)(vs0 + i * 32768), (LAS unsigned*)(lds + B_VB + i * 16384 + wave * 2048), 16, 0, 0);
        __builtin_amdgcn_global_load_lds((const unsigned*)(vs1 + i * 32768), (LAS unsigned*)(lds + B_VB + i * 16384 + wave * 2048 + 1024), 16, 0, 0); }
    }
    B_WAITV(0); B_BAR();
    f32x16 A0, A1;
    b_qk(lds, Qw, kaddr, bvs, A0, A1);
    B_BAR();
    bf16x8 pp[4];
#pragma unroll
    for (int s4 = 0; s4 < 4; ++s4) pp[s4] = (bf16x8){0, 0, 0, 0, 0, 0, 0, 0};
    for (int t = 0; t < SEQ / 64; t += 4) {
        b_fstep<0>(lds, t, td, c, wave, tile0, loff, kaddr, vaddr, Qw, bvs, A0, A1, O, pp, m, l, qpos, hi, slope2);
        b_fstep<1>(lds, t + 1, td, c, wave, tile0, loff, kaddr, vaddr, Qw, bvs, A0, A1, O, pp, m, l, qpos, hi, slope2);
        b_fstep<2>(lds, t + 2, td, c, wave, tile0, loff, kaddr, vaddr, Qw, bvs, A0, A1, O, pp, m, l, qpos, hi, slope2);
        b_fstep<3>(lds, t + 3, td, c, wave, tile0, loff, kaddr, vaddr, Qw, bvs, A0, A1, O, pp, m, l, qpos, hi, slope2);
    }
    {
        const LAS unsigned char* Vb = lds + B_VB + ((SEQ / 64 - 1) & 3) * 16384;
#pragma unroll
        for (int db = 0; db < 4; ++db) {
            bf16x8 vf[4];
#pragma unroll
            for (int s4 = 0; s4 < 4; ++s4) vf[s4] = *(const LAS bf16x8*)(Vb + vaddr[s4] + db * 4096);
#pragma unroll
            for (int s4 = 0; s4 < 4; ++s4) O[db] = MFMA32(vf[s4], pp[s4], O[db]);
        }
    }
    B_WAITV(0); B_BAR();
    l = xhalf_sum(l);
    const float inv = 1.0f / l;
    LAS float* X = (LAS float*)lds;
    if (c == 1) {
#pragma unroll
        for (int db = 0; db < 4; ++db)
#pragma unroll
            for (int t = 0; t < 16; ++t) X[(sb * 64 + db * 16 + t) * 64 + lane] = O[db][t] * inv;
    }
    __syncthreads();
    if (c == 0) {
        float ss = 0.f;
#pragma unroll
        for (int db = 0; db < 4; ++db)
#pragma unroll
            for (int t = 0; t < 16; ++t) { const float o = O[db][t] * inv - lam * X[(sb * 64 + db * 16 + t) * 64 + lane]; O[db][t] = o; ss += o * o; }
        ss = xhalf_sum(ss);
        const float rstd = 1.0f / sqrtf(ss * (1.0f / 128.0f) + EPS);
        bf16* orow = cat + (rowbase + qpos) * DM + 1024 + h * 128 + 4 * hi;
#pragma unroll
        for (int db = 0; db < 4; ++db)
#pragma unroll
            for (int g = 0; g < 4; ++g) { v2u w; w.x = cvtpk(O[db][4 * g] * rstd, O[db][4 * g + 1] * rstd); w.y = cvtpk(O[db][4 * g + 2] * rstd, O[db][4 * g + 3] * rstd);
                *(v2u*)(orow + 32 * db + 8 * g) = w; }
    }
    __syncthreads();
}

constexpr int A_KT = 64 * 272, A_VOFF = 2 * A_KT, A_SSQ = A_VOFF + 2 * 18432;
__device__ __forceinline__ void attn_unit_A(LAS unsigned char* lds, const bf16* proj, const bf16* VtAll, bf16* cat, const float* a_sink, int b, int n, int tid, int wave, int lane) {
    asm volatile("" : "+v"(lane), "+v"(tid));
    const int w = wave, g = w >> 2, r = lane & 31, hi = lane >> 5;
    const size_t rowbase = (size_t)b * SEQ;
    const float c1 = 0.08838834764831845f * LOG2E, slope2 = __builtin_amdgcn_exp2f(-0.5f * (float)(w + 1)) * LOG2E, sinkv = a_sink[w] * LOG2E;
    LAS float* ssq = (LAS float*)(lds + A_SSQ);
    for (int sbk = 0; sbk < 4; ++sbk) {
        const int p0 = n * 128 + sbk * 32, qpos = p0 + r;
        bf16x8 qf[8];
#pragma unroll
        for (int s = 0; s < 8; ++s) qf[s] = *(const bf16x8*)(proj + (rowbase + qpos) * INC + O_QA + w * 128 + 16 * s + 8 * hi);
        f32x16 O[4];
#pragma unroll
        for (int db = 0; db < 4; ++db)
#pragma unroll
            for (int t = 0; t < 16; ++t) O[db][t] = 0.f;
        float m = sinkv, l = (hi == 0) ? 1.0f : 0.0f;
        const int ts = ((p0 - 128) >> 6) << 6;
        for (int i = 0; i < 5; ++i) {
            const int key0 = ts + 64 * i;
            if (key0 < 0 || key0 >= SEQ) continue;
            __syncthreads();
#pragma unroll
            for (int j = 0; j < 4; ++j) { const int idx = tid + 512 * j, gk = idx >> 10, rem = idx & 1023;
                { const int row = rem >> 4, ch = rem & 15;
                  const v4u v = *(const v4u*)(proj + (rowbase + key0 + row) * INC + O_KA + gk * 128 + ch * 8);
                  *(LAS v4u*)(lds + gk * A_KT + row * 272 + ch * 16) = v; }
                { const int d = rem >> 3, ch = rem & 7;
                  const v4u v = *(const v4u*)(VtAll + ((size_t)((b * 2 + gk) * 128 + d)) * SEQ + key0 + ch * 8);
                  *(LAS v4u*)(lds + A_VOFF + gk * 18432 + d * 144 + ch * 16) = v; } }
            __syncthreads();
            attn_tile<128, 1>(lds + g * A_KT, lds + A_VOFF + g * 18432, qf, O, m, l, qpos, key0, c1, slope2, lane);
        }
        l += __shfl_xor(l, 32);
        const float inv = 1.0f / l;
        float ss = 0.f;
#pragma unroll
        for (int db = 0; db < 4; ++db)
#pragma unroll
            for (int t = 0; t < 16; ++t) { const float o = O[db][t] * inv; O[db][t] = o; ss += o * o; }
        ss += __shfl_xor(ss, 32);
        if (hi == 0) ssq[w * 128 + sbk * 32 + r] = ss;
        bf16* orow = cat + (rowbase + qpos) * DM + w * 128 + 4 * hi;
#pragma unroll
        for (int db = 0; db < 4; ++db)
#pragma unroll
            for (int gq = 0; gq < 4; ++gq) { v2u ww; ww.x = cvtpk(O[db][4 * gq], O[db][4 * gq + 1]); ww.y = cvtpk(O[db][4 * gq + 2], O[db][4 * gq + 3]);
                *(v2u*)(orow + 32 * db + 8 * gq) = ww; }
    }
    __syncthreads();
    for (int sbk = 0; sbk < 4; ++sbk) {
        const int ql = sbk * 32 + r;
        float tot = 0.f;
#pragma unroll
        for (int w2 = 0; w2 < 8; ++w2) tot += ssq[w2 * 128 + ql];
        const float rstd = 1.0f / sqrtf(tot * (1.0f / 1024.0f) + EPS);
        bf16* orow = cat + (rowbase + n * 128 + ql) * DM + w * 128 + 4 * hi;
#pragma unroll
        for (int db = 0; db < 4; ++db)
#pragma unroll
            for (int gq = 0; gq < 4; ++gq) { v2u* p = (v2u*)(orow + 32 * db + 8 * gq); const v2u ww = *p;
                v2u o; o.x = cvtpk(bf_lo(ww.x) * rstd, bf_hi(ww.x) * rstd); o.y = cvtpk(bf_lo(ww.y) * rstd, bf_hi(ww.y) * rstd); *p = o; }
    }
    __syncthreads();
}

__global__ void __launch_bounds__(NTHR, 2) fwd_mega(Args a) {
    extern __shared__ __attribute__((aligned(16))) unsigned char lds_raw[];
    LAS unsigned char* lds = (LAS unsigned char*)lds_raw;
    cg::grid_group grid = cg::this_grid();
    int tid = threadIdx.x, lane = tid & 63; const int wave = __builtin_amdgcn_readfirstlane(tid >> 6);
#define FRESH_LANE() asm volatile("" : "+v"(lane), "+v"(tid))
    const int G = gridDim.x, bx = blockIdx.x;
    const int gw = bx * NWAVES + wave, ngw = G * NWAVES;
    unsigned char* ws = a.ws;
    float* mod = (float*)(ws + WS_MOD);
    bf16* Win_t = (bf16*)(ws + WS_WIN); bf16* Wo_t = (bf16*)(ws + WS_WO); bf16* Wgu_t = (bf16*)(ws + WS_WGU); bf16* Wd_t = (bf16*)(ws + WS_WD);
    bf16* Hb = (bf16*)(ws + WS_H); bf16* cat = (bf16*)(ws + WS_CAT); bf16* proj = (bf16*)(ws + WS_PROJ); bf16* VtAll = (bf16*)(ws + WS_VT); unsigned char* KVB = ws + WS_KVB; bf16* FFb = (bf16*)(ws + WS_FF);

    FRESH_LANE();
    {
        for (int it = gw; it < 48 * 32; it += ngw) ada_item(a.c, a.w_ada, mod, it, lane);
        LAS float* scr = (LAS float*)(lds + wave * 16384);
        constexpr int I_IN = (DM / 64) * (INC / 32), I_O = (DM / 64) * (DM / 32), I_G = (DM / 64) * (DFF / 32), I_D = (DFF / 64) * (DM / 32);
        constexpr int NIT = I_IN + I_O + 2 * I_G + I_D;
        for (int it = gw; it < NIT; it += ngw) {
            int r = it;
            if (r < I_IN) { transpose_item<0>(a.w_in, DM, INC, Win_t, nullptr, nullptr, scr, r, lane); continue; } r -= I_IN;
            if (r < I_O) { transpose_item<3>(a.w_o, DM, DM, Wo_t, a.a_gain, a.subg, scr, r, lane); continue; } r -= I_O;
            if (r < I_G) { transpose_item<1>(a.w_gate, DM, DFF, Wgu_t, nullptr, nullptr, scr, r, lane); continue; } r -= I_G;
            if (r < I_G) { transpose_item<2>(a.w_up, DM, DFF, Wgu_t, nullptr, nullptr, scr, r, lane); continue; } r -= I_G;
            transpose_item<0>(a.w_down, DFF, DM, Wd_t, nullptr, nullptr, scr, r, lane);
        }
    }
    grid.sync();
    FRESH_LANE();
    norm_mod_phase(a.x, Hb, a.g1n, mod, a.b_ada, 0, DM, gw, ngw, lane);
    grid.sync();
    {
        pg8::Gemm g{Hb, Win_t, MTOK, INC, DM}; pg8::StaticOrder S; S.init(MTOK, INC, G, bx);
        pg8::EpiStoreBf16 E{proj, INC, 0.08838834764831845f * LOG2E, 0.125f * LOG2E, KVB};
        pg8::gemm_phase<pg8::EpiStoreBf16, pg8::StaticOrder, true, true>(lds, g, S, E);
    }
    grid.sync();
    FRESH_LANE();
    {
        LAS unsigned short* T = (LAS unsigned short*)(lds + wave * 8448);
        for (int it = gw; it < NB * 10 * 2 * 128; it += ngw) vt_item(proj, VtAll, KVB, T, it, lane);
    }
    grid.sync();
    FRESH_LANE();
    {
        float s1 = 0.f, s2 = 0.f;
        for (int i = 0; i < 64; ++i) { s1 += a.lq1[i] * a.lk1[i]; s2 += a.lq2[i] * a.lk2[i]; }
        const float lam = __expf(s1) - __expf(s2) + 0.2f;
        for (int u = bx; u < NB * 64; u += G) attn_unit_A(lds, proj, VtAll, cat, a.a_sink, u >> 6, u & 63, tid, wave, lane);
        for (int v = bx; v < NB * 8 * 64; v += G) {
            const int xcd = v & 7, j = v >> 3, idx = j & 31, rnd = j >> 5;
            const int bh = xcd * 4 + (rnd >> 1), qb = (rnd & 1) * 32 + idx;
            attn_unit_B(lds, proj, KVB, cat, bh >> 3, bh & 7, qb, lam, tid, wave, lane);
        }
    }
    grid.sync();
    {
        pg8::Gemm g{cat, Wo_t, MTOK, DM, DM}; pg8::StaticOrder S; S.init(MTOK, DM, G, bx);
        pg8::EpiResGate E{a.x, a.out, DM, mod + 2 * DM, a.b_ada + 2 * DM};
        pg8::gemm_phase<pg8::EpiResGate, pg8::StaticOrder, true, true>(lds, g, S, E);
    }
    grid.sync();
    FRESH_LANE();
    norm_mod_phase(a.out, Hb, a.g2n, mod, a.b_ada, 3 * DM, 4 * DM, gw, ngw, lane);
    grid.sync();
    {
        pg8::Gemm g{Hb, Wgu_t, MTOK, 2 * DFF, DM}; pg8::StaticOrder S; S.init(MTOK, 2 * DFF, G, bx);
        pg8::EpiSwiGLU E{FFb, DFF};
        pg8::gemm_phase<pg8::EpiSwiGLU, pg8::StaticOrder, true, true>(lds, g, S, E);
    }
    grid.sync();
    {
        pg8::Gemm g{FFb, Wd_t, MTOK, DM, DFF}; pg8::StaticOrder S; S.init(MTOK, DM, G, bx);
        pg8::EpiResGate E{a.out, a.out, DM, mod + 5 * DM, a.b_ada + 5 * DM};
        pg8::gemm_phase<pg8::EpiResGate, pg8::StaticOrder, true, true>(lds, g, S, E);
    }
    grid.sync();
    FRESH_LANE();
    final_norm_phase(a.out, a.gfin, gw, ngw, lane);
}

extern "C" void kernel_launch(void* const* d_in, const int* in_sizes, int n_in, void* d_out, int out_size, void* d_ws, size_t ws_size, hipStream_t stream) {
    static int grid = 0;
    if (grid == 0) {
        if (n_in != 19 || in_sizes[0] != MTOK * DM || out_size != MTOK * DM || ws_size < WS_END) {
            fprintf(stderr, "kernel_launch: unexpected shapes (n_in %d, in0 %d, out %d, ws %zu; need ws >= %zu)\n", n_in, n_in > 0 ? in_sizes[0] : -1, out_size, ws_size, (size_t)WS_END); grid = -1; return; }
        int dev = 0, cus = 0, per_cu = 0;
        if (hipGetDevice(&dev) != hipSuccess || hipDeviceGetAttribute(&cus, hipDeviceAttributeMultiprocessorCount, dev) != hipSuccess) { grid = -1; return; }
        if (hipFuncSetAttribute((const void*)fwd_mega, hipFuncAttributeMaxDynamicSharedMemorySize, LDS_BYTES) != hipSuccess) { fprintf(stderr, "kernel_launch: hipFuncSetAttribute failed\n"); grid = -1; return; }
        if (hipOccupancyMaxActiveBlocksPerMultiprocessor(&per_cu, (const void*)fwd_mega, NTHR, LDS_BYTES) != hipSuccess || per_cu < 1) { fprintf(stderr, "kernel_launch: occupancy query says %d\n", per_cu); per_cu = 1; }
        (void)hipGetLastError();
        grid = cus;
    }
    if (grid < 0) return;
    (void)hipMemsetAsync((char*)d_ws + WS_MOD, 0, (size_t)NB * NMODC * 4, stream);
    Args a{};
    a.x = (const float*)d_in[0]; a.c = (const float*)d_in[1]; a.w_ada = (const float*)d_in[2]; a.b_ada = (const float*)d_in[3]; a.g1n = (const float*)d_in[4];
    a.w_in = (const float*)d_in[5]; a.a_sink = (const float*)d_in[6]; a.a_gain = (const float*)d_in[7]; a.lq1 = (const float*)d_in[8]; a.lk1 = (const float*)d_in[9];
    a.lq2 = (const float*)d_in[10]; a.lk2 = (const float*)d_in[11]; a.subg = (const float*)d_in[12]; a.w_o = (const float*)d_in[13]; a.g2n = (const float*)d_in[14];
    a.w_gate = (const float*)d_in[15]; a.w_up = (const float*)d_in[16]; a.w_down = (const float*)d_in[17]; a.gfin = (const float*)d_in[18];
    a.out = (float*)d_out; a.ws = (unsigned char*)d_ws;
    void* args[] = {&a};
    const hipError_t e = hipLaunchCooperativeKernel((const void*)fwd_mega, dim3(grid), dim3(NTHR), args, LDS_BYTES, stream);
    if (e != hipSuccess) fprintf(stderr, "kernel_launch: cooperative launch failed: %s (grid %d)\n", hipGetErrorString(e), grid);
}
```

```cpp
#include <hip/hip_runtime.h>
#include <hip/hip_cooperative_groups.h>
#include <cstdio>
#include <cstdint>
namespace cg = cooperative_groups;
namespace pg8 {
#define PG8_LAS __attribute__((address_space(3)))
typedef unsigned short bf16_t;
typedef short bf16x8 __attribute__((ext_vector_type(8)));
typedef float f32x4 __attribute__((ext_vector_type(4)));
typedef unsigned u32x4 __attribute__((ext_vector_type(4)));
constexpr int BM = 256, BK = 64, HALF = 128, HTB = HALF * BK * 2  , STAGE_BYTES = 8 * HTB, NXCD = 8, WGM = 8;

__host__ __device__ __forceinline__ int lds_byte(int r, int c) { const int st = (r >> 4) * 2 + (c >> 5), rr = r & 15, cc = c & 31, ob = rr * 64 + cc * 2; return st * 1024 + (ob ^ (((ob >> 9) & 1) << 5)); }
__host__ __device__ __forceinline__ void stage_rc(int b, int& R, int& C) { const int st = b / 1024, sb = b % 1024, swz = sb ^ (((sb >> 9) & 1) << 5); R = (st >> 1) * 16 + swz / 64; C = (st & 1) * 32 + (swz % 64) / 2; }
__host__ __device__ __forceinline__ int perm32(int rho) { const int n = rho >> 4, i = rho & 15; return 8 * (i >> 2) + 4 * n + (i & 3); }

struct Unit { int pm, pn; };
struct Gemm { const bf16_t* A; const bf16_t* Bt; int M, N, K; };

struct StaticOrder {
    int nM, nN, nwg, G, c;
    __host__ __device__ void init(int M, int N, int G_, int c_) { nM = M / BM; nN = N / BM; nwg = nM * nN; G = G_; c = c_; }
    __host__ __device__ bool next(int i, Unit& u) const {
        const long L = (long)i * G + c; if (L >= nwg) return false;
        int wgid = (int)L; { const int q = nwg / NXCD, r = nwg % NXCD, xcd = wgid % NXCD, off = wgid / NXCD; wgid = (xcd < r ? xcd * (q + 1) : r * (q + 1) + (xcd - r) * q) + off; }
        const int nig = WGM * nN, gid = wgid / nig, fm = gid * WGM, gsz = (nM - fm) < WGM ? (nM - fm) : WGM;
        u.pm = fm + ((wgid % nig) % gsz); u.pn = (wgid % nig) / gsz; return true;
    }
    __device__ __forceinline__ void a_ready(const Unit&) const {}
    __device__ __forceinline__ void done(const Unit&) const {}
};
__device__ __forceinline__ unsigned cvt_pk_bf16(float lo, float hi) { unsigned r; asm volatile("v_cvt_pk_bf16_f32 %0, %1, %2" : "=v"(r) : "v"(lo), "v"(hi)); return r; }
typedef float f32x2 __attribute__((ext_vector_type(2)));
typedef __bf16 bf16x2v __attribute__((ext_vector_type(2)));
__device__ __forceinline__ unsigned cvtpk(float lo, float hi) { f32x2 v = {lo, hi}; bf16x2v b = __builtin_convertvector(v, bf16x2v); return __builtin_bit_cast(unsigned, b); }

struct EpiStoreBf16 {
    static constexpr bool PERM = true, AFTER_DRAIN = false;
    bf16_t* O; int ldc; float scA, scB; unsigned char* kvb;
    __device__ __forceinline__ void operator()(const f32x4 (&acc)[2][2][4][2], const Unit& u, int wr, int wc, int fr, int fq) const {
        const int row0 = u.pm * BM + wr * 64 + fr, col0 = u.pn * BM + wc * 32 + 8 * fq;
        const float sc = (u.pn < 4) ? scA : ((u.pn >= 6 && u.pn < 10) ? scB : 1.0f);
        const bool kd = (u.pn >= 10 && u.pn < 14);
#pragma unroll
        for (int ai = 0; ai < 2; ++ai)
#pragma unroll
            for (int m = 0; m < 4; ++m) { const int row = row0 + ai * HALF + m * 16; bf16_t* rowp = O + (size_t)row * ldc + col0;
                const int b = row >> 13, tok = row & 8191, rr = tok & 63;
                unsigned char* kp = kvb + ((size_t)((b * 8 + 2 * (u.pn - 10)) * 128 + (tok >> 6))) * 32768 + (wc >> 1) * 8192 + rr * 128 + ((((wc & 1) * 4 + fq) ^ ((rr >> 1) & 7)) << 4);
#pragma unroll
                for (int bj = 0; bj < 2; ++bj) { const f32x4 v0 = acc[ai][bj][m][0] * sc, v1 = acc[ai][bj][m][1] * sc;
                    u32x4 w; w.x = cvtpk(v0[0], v0[1]); w.y = cvtpk(v0[2], v0[3]); w.z = cvtpk(v1[0], v1[1]); w.w = cvtpk(v1[2], v1[3]);
                    if (kd) *(u32x4*)(kp + (size_t)bj * 128 * 32768) = w; else *(u32x4*)(rowp + bj * HALF) = w; } }
    }
};
struct EpiResGate {
    static constexpr bool PERM = false, AFTER_DRAIN = false;
    const float* base; float* out; int ldc; const float* modg; const float* badag;
    __device__ __forceinline__ void operator()(const f32x4 (&acc)[2][2][4][2], const Unit& u, int wr, int wc, int fr, int fq) const {
        const int row0 = u.pm * BM + wr * 64 + fr, col0 = u.pn * BM + wc * 32 + 4 * fq, b = u.pm >> 5;
        f32x4 gv[2][2];
#pragma unroll
        for (int bj = 0; bj < 2; ++bj)
#pragma unroll
            for (int n = 0; n < 2; ++n) gv[bj][n] = *(const f32x4*)(modg + (size_t)b * 12288 + col0 + bj * HALF + n * 16) + *(const f32x4*)(badag + col0 + bj * HALF + n * 16);
#pragma unroll
        for (int ai = 0; ai < 2; ++ai)
#pragma unroll
            for (int m = 0; m < 4; ++m) { const size_t off = (size_t)(row0 + ai * HALF + m * 16) * ldc + col0;
#pragma unroll
                for (int bj = 0; bj < 2; ++bj)
#pragma unroll
                    for (int n = 0; n < 2; ++n) { const f32x4 bs = *(const f32x4*)(base + off + bj * HALF + n * 16);
                        *(f32x4*)(out + off + bj * HALF + n * 16) = bs + gv[bj][n] * acc[ai][bj][m][n]; }
                asm volatile("" ::: "memory"); }
    }
};
struct EpiSwiGLU {
    static constexpr bool PERM = true, AFTER_DRAIN = false;
    bf16_t* O; int ldc;
    static __device__ __forceinline__ float sw(float g, float up) { return g * __builtin_amdgcn_rcpf(1.0f + __builtin_amdgcn_exp2f(-1.44269504f * g)) * up; }
    __device__ __forceinline__ void operator()(const f32x4 (&acc)[2][2][4][2], const Unit& u, int wr, int wc, int fr, int fq) const {
        const int row0 = u.pm * BM + wr * 64 + fr, col0 = u.pn * HALF + wc * 32 + 8 * fq;
#pragma unroll
        for (int ai = 0; ai < 2; ++ai)
#pragma unroll
            for (int m = 0; m < 4; ++m) { bf16_t* rowp = O + (size_t)(row0 + ai * HALF + m * 16) * ldc + col0;
                const f32x4 g0 = acc[ai][0][m][0], g1 = acc[ai][0][m][1], u0 = acc[ai][1][m][0], u1 = acc[ai][1][m][1];
                u32x4 w; w.x = cvtpk(sw(g0[0], u0[0]), sw(g0[1], u0[1])); w.y = cvtpk(sw(g0[2], u0[2]), sw(g0[3], u0[3]));
                w.z = cvtpk(sw(g1[0], u1[0]), sw(g1[1], u1[1])); w.w = cvtpk(sw(g1[2], u1[2]), sw(g1[3], u1[3]));
                *(u32x4*)rowp = w; }
    }
};

template <class Epi, class Sched, bool ALIGN_EPI = false, bool SP2 = false>
__device__ __forceinline__ void gemm_phase(PG8_LAS unsigned char* lds, const Gemm g, const Sched& S, const Epi& E) {
    int tid_ = threadIdx.x; asm volatile("" : "+v"(tid_));
    const int tid = tid_, wid = __builtin_amdgcn_readfirstlane(tid >> 6), lane = tid & 63, wr = wid >> 2, wc = wid & 3, fr = lane & 15, fq = lane >> 4;
    const int K = g.K, nt = K / BK;
    unsigned voffA[2], voffB[2];
#pragma unroll
    for (int i = 0; i < 2; ++i) { int R, C; stage_rc(tid * 16 + i * 8192, R, C); const int Rb = Epi::PERM ? ((R & ~31) + perm32(R & 31)) : R;
        voffA[i] = (unsigned)(R * K + C) * 2u; voffB[i] = (unsigned)(Rb * K + C) * 2u; }
    const size_t kstep = (size_t)(BK * 2);
    const size_t hstep = (size_t)HALF * K * 2;
    const size_t tstep = 2 * hstep;
    const unsigned ldsw = (unsigned)wid * 1024u;
    const int aoff = lds_byte(wr * 64 + fr, fq * 8), boff = lds_byte(wc * 32 + fr, fq * 8);
#define PG8_SA(b, h) (((b) * 2 + (h)) * HTB)
#define PG8_SB(b, h) ((4 + (b) * 2 + (h)) * HTB)
#define PG8_STAGE(bufoff, gbase, voff) do { _Pragma("unroll") for (int _i = 0; _i < 2; ++_i) \
        __builtin_amdgcn_global_load_lds((const unsigned*)((const char*)(gbase) + (voff)[_i]), (PG8_LAS unsigned*)(lds + (bufoff) + ldsw + _i * 8192), 16, 0, 0); } while (0)
#define PG8_LDA(dst, b, h) do { _Pragma("unroll") for (int m = 0; m < 4; ++m) _Pragma("unroll") for (int k = 0; k < 2; ++k) dst[m][k] = *(const PG8_LAS bf16x8*)(lds + PG8_SA(b, h) + aoff + m * 2048 + k * 1024); } while (0)
#define PG8_LDB(dst, b, h) do { _Pragma("unroll") for (int n = 0; n < 2; ++n) _Pragma("unroll") for (int k = 0; k < 2; ++k) dst[n][k] = *(const PG8_LAS bf16x8*)(lds + PG8_SB(b, h) + boff + n * 2048 + k * 1024); } while (0)
#define PG8_MMA(ai, bj, At, Bt) do { __builtin_amdgcn_s_setprio(1); _Pragma("unroll") for (int m = 0; m < 4; ++m) _Pragma("unroll") for (int n = 0; n < 2; ++n) _Pragma("unroll") for (int k = 0; k < 2; ++k) \
        acc[ai][bj][m][n] = __builtin_amdgcn_mfma_f32_16x16x32_bf16(Bt[n][k], At[m][k], acc[ai][bj][m][n], 0, 0, 0); __builtin_amdgcn_s_setprio(0); } while (0)
#define PG8_WAIT_V(n) asm volatile("s_waitcnt vmcnt(" #n ")" ::: "memory")
#define PG8_WAIT_L(n) asm volatile("s_waitcnt lgkmcnt(" #n ")" ::: "memory")
#define PG8_BAR __builtin_amdgcn_s_barrier()
#define PG8_SCHED __builtin_amdgcn_sched_barrier(0)
    Unit cur, nxt; int ui = 0;
    if (!S.next(0, cur)) return;
    f32x4 acc[2][2][4][2];
#pragma unroll
    for (int a = 0; a < 2; ++a)
#pragma unroll
        for (int b = 0; b < 2; ++b)
#pragma unroll
            for (int m = 0; m < 4; ++m)
#pragma unroll
                for (int n = 0; n < 2; ++n) acc[a][b][m][n] = (f32x4){0.f, 0.f, 0.f, 0.f};
    bf16x8 At[4][2], B0[2][2], B1[2][2];
    const char* cA = (const char*)g.A + (size_t)cur.pm * tstep; const char* cB = (const char*)g.Bt + (size_t)cur.pn * tstep;
    S.a_ready(cur);
    if constexpr (SP2) {
        PG8_STAGE(PG8_SB(0, 0), cB, voffB); PG8_STAGE(PG8_SB(0, 1), cB + hstep, voffB); PG8_STAGE(PG8_SA(0, 0), cA, voffA); PG8_STAGE(PG8_SA(0, 1), cA + hstep, voffA);
        if (wr == 1) PG8_BAR;
        PG8_WAIT_V(2); PG8_BAR;
        PG8_STAGE(PG8_SB(1, 0), cB + kstep, voffB); PG8_STAGE(PG8_SA(1, 0), cA + kstep, voffA); PG8_STAGE(PG8_SB(1, 1), cB + hstep + kstep, voffB);
        PG8_WAIT_V(6); PG8_BAR;
    } else {
        PG8_STAGE(PG8_SB(0, 0), cB, voffB); PG8_STAGE(PG8_SA(0, 0), cA, voffA); PG8_STAGE(PG8_SB(0, 1), cB + hstep, voffB); PG8_STAGE(PG8_SA(0, 1), cA + hstep, voffA);
        if (wr == 1) PG8_BAR;
        PG8_WAIT_V(4); PG8_BAR;
        PG8_STAGE(PG8_SB(1, 0), cB + kstep, voffB); PG8_STAGE(PG8_SA(1, 0), cA + kstep, voffA); PG8_STAGE(PG8_SB(1, 1), cB + hstep + kstep, voffB);
        PG8_WAIT_V(6); PG8_BAR;
    }
    for (;;) {
        const bool has_next = S.next(ui + 1, nxt);
        const char* nA = has_next ? (const char*)g.A + (size_t)nxt.pm * tstep : cA; const char* nB = has_next ? (const char*)g.Bt + (size_t)nxt.pn * tstep : cB;
        for (int t = 0; t < nt; t += 2) {
            const bool last = (t == nt - 2);
            const char* a1 = cA + (size_t)(t + 1) * kstep;
            const char* a2 = last ? nA : cA + (size_t)(t + 2) * kstep; const char* b2 = last ? nB : cB + (size_t)(t + 2) * kstep;
            const char* a3 = a2 + kstep; const char* b3 = b2 + kstep;
            if (last && has_next) S.a_ready(nxt);
            if constexpr (SP2) {
            PG8_LDB(B0, 0, 0); PG8_LDB(B1, 0, 1); PG8_SCHED; PG8_LDA(At, 0, 0); PG8_STAGE(PG8_SA(1, 1), a1 + hstep, voffA);
            PG8_WAIT_V(8); PG8_WAIT_L(0); PG8_BAR; PG8_MMA(0, 0, At, B0); PG8_MMA(0, 1, At, B1); PG8_BAR; PG8_SCHED;
            PG8_LDA(At, 0, 1); PG8_STAGE(PG8_SB(0, 0), b2, voffB); PG8_STAGE(PG8_SB(0, 1), b2 + hstep, voffB); PG8_STAGE(PG8_SA(0, 0), a2, voffA);
            PG8_WAIT_V(8); PG8_WAIT_L(0); PG8_BAR; PG8_MMA(1, 0, At, B0); PG8_MMA(1, 1, At, B1); PG8_BAR; PG8_SCHED;
            PG8_LDB(B0, 1, 0); PG8_LDB(B1, 1, 1); PG8_SCHED; PG8_LDA(At, 1, 0); PG8_STAGE(PG8_SA(0, 1), a2 + hstep, voffA);
            PG8_WAIT_V(8); PG8_WAIT_L(0); PG8_BAR; PG8_MMA(0, 0, At, B0); PG8_MMA(0, 1, At, B1); PG8_BAR; PG8_SCHED;
            PG8_LDA(At, 1, 1); PG8_STAGE(PG8_SB(1, 0), b3, voffB); PG8_STAGE(PG8_SB(1, 1), b3 + hstep, voffB); PG8_STAGE(PG8_SA(1, 0), a3, voffA);
            PG8_WAIT_V(8); PG8_WAIT_L(0); PG8_BAR; PG8_MMA(1, 0, At, B0); PG8_MMA(1, 1, At, B1); PG8_BAR; PG8_SCHED;
            } else {
            PG8_LDB(B0, 0, 0); PG8_SCHED; PG8_LDA(At, 0, 0); PG8_STAGE(PG8_SA(1, 1), a1 + hstep, voffA);
            PG8_WAIT_L(8); PG8_BAR; PG8_WAIT_L(0); PG8_MMA(0, 0, At, B0); PG8_BAR; PG8_SCHED;
            PG8_LDB(B1, 0, 1); PG8_STAGE(PG8_SB(0, 0), b2, voffB);
            PG8_BAR; PG8_WAIT_L(0); PG8_MMA(0, 1, At, B1); PG8_BAR;
            PG8_LDA(At, 0, 1); PG8_STAGE(PG8_SA(0, 0), a2, voffA);
            PG8_BAR; PG8_WAIT_L(0); PG8_MMA(1, 0, At, B0); PG8_BAR; PG8_SCHED;
            PG8_STAGE(PG8_SB(0, 1), b2 + hstep, voffB);
            PG8_WAIT_V(6); PG8_BAR; PG8_MMA(1, 1, At, B1); PG8_BAR;
            PG8_LDB(B0, 1, 0); PG8_SCHED; PG8_LDA(At, 1, 0); PG8_STAGE(PG8_SA(0, 1), a2 + hstep, voffA);
            PG8_WAIT_L(8); PG8_BAR; PG8_WAIT_L(0); PG8_MMA(0, 0, At, B0); PG8_BAR; PG8_SCHED;
            PG8_LDB(B1, 1, 1); PG8_STAGE(PG8_SB(1, 0), b3, voffB);
            PG8_BAR; PG8_WAIT_L(0); PG8_MMA(0, 1, At, B1); PG8_BAR;
            PG8_LDA(At, 1, 1); PG8_STAGE(PG8_SA(1, 0), a3, voffA);
            PG8_BAR; PG8_WAIT_L(0); PG8_MMA(1, 0, At, B0); PG8_BAR; PG8_SCHED;
            PG8_STAGE(PG8_SB(1, 1), b3 + hstep, voffB);
            PG8_WAIT_V(6); PG8_BAR; PG8_MMA(1, 1, At, B1); PG8_BAR;
            }
        }
        if constexpr (ALIGN_EPI) { if (wr == 0) PG8_BAR; }
        if constexpr (!Epi::AFTER_DRAIN) { E(acc, cur, wr, wc, fr, fq); S.done(cur); }
        if (!has_next) break;
#pragma unroll
        for (int a = 0; a < 2; ++a)
#pragma unroll
            for (int b = 0; b < 2; ++b)
#pragma unroll
                for (int m = 0; m < 4; ++m)
#pragma unroll
                    for (int n = 0; n < 2; ++n) acc[a][b][m][n] = (f32x4){0.f, 0.f, 0.f, 0.f};
        cur = nxt; cA = nA; cB = nB; ++ui;
        if constexpr (ALIGN_EPI) { if (wr == 1) PG8_BAR; }
    }
    PG8_WAIT_V(0);
    if constexpr (!ALIGN_EPI) { if (wr == 0) PG8_BAR; }
    PG8_BAR;
    if constexpr (Epi::AFTER_DRAIN) { E.fused(acc, cur, wr, wc, fr, fq, lds, wid, lane); S.done(cur); }
#undef PG8_SA
#undef PG8_SB
#undef PG8_STAGE
#undef PG8_LDA
#undef PG8_LDB
#undef PG8_MMA
#undef PG8_WAIT_V
#undef PG8_WAIT_L
#undef PG8_BAR
#undef PG8_SCHED
}
}

constexpr int NB = 4, SEQ = 8192, DM = 2048, MTOK = NB * SEQ, INC = 4608, DFF = 5632, NMODC = 6 * DM;
constexpr int NWAVES = 8, NTHR = 512;
constexpr float EPS = 1e-6f, LOG2E = 1.44269504088896f;
constexpr int O_QA = 0, O_KA = 1024, O_VA = 1280, O_QD = 1536, O_KD = 2560, O_VD = 3584;
constexpr size_t WS_MOD = 0;
constexpr size_t WS_BAR = 262144;
constexpr size_t WS_WIN = 1u << 20;
constexpr size_t WS_WO = WS_WIN + (size_t)INC * DM * 2;
constexpr size_t WS_WGU = WS_WO + (size_t)DM * DM * 2;
constexpr size_t WS_WD = WS_WGU + (size_t)2 * DFF * DM * 2;
constexpr size_t WS_H = WS_WD + (size_t)DM * DFF * 2;
constexpr size_t WS_CAT = WS_H + (size_t)MTOK * DM * 2;
constexpr size_t WS_PROJ = WS_CAT + (size_t)MTOK * DM * 2;
constexpr size_t WS_VT = WS_PROJ + (size_t)MTOK * INC * 2;
constexpr size_t WS_KVB = WS_VT + (size_t)NB * 2 * 128 * SEQ * 2;
constexpr size_t WS_END = WS_KVB + (size_t)NB * 8 * 128 * 32768;
constexpr size_t WS_FF = WS_PROJ;
static_assert(WS_FF + (size_t)MTOK * DFF * 2 <= WS_END, "ff overlay");
constexpr int LDS_BYTES = 163840;

#define LAS __attribute__((address_space(3)))
typedef unsigned short bf16;
typedef unsigned v4u __attribute__((ext_vector_type(4)));
typedef unsigned v2u __attribute__((ext_vector_type(2)));
typedef float f32x4 __attribute__((ext_vector_type(4)));
typedef float f32x16 __attribute__((ext_vector_type(16)));
typedef short bf16x8 __attribute__((ext_vector_type(8)));
#define MFMA32(a, b, c) __builtin_amdgcn_mfma_f32_32x32x16_bf16((a), (b), (c), 0, 0, 0)
using pg8::cvtpk;

__device__ __forceinline__ float wave_sum(float v) {
#pragma unroll
    for (int o = 1; o < 64; o <<= 1) v += __shfl_xor(v, o);
    return v;
}
__device__ __forceinline__ float bf_lo(unsigned w) { return __uint_as_float(w << 16); }
__device__ __forceinline__ float bf_hi(unsigned w) { return __uint_as_float(w & 0xffff0000u); }

struct Args {
    const float *x, *c, *w_ada, *b_ada, *g1n, *w_in, *a_sink, *a_gain, *lq1, *lk1, *lq2, *lk2, *subg, *w_o, *g2n, *w_gate, *w_up, *w_down, *gfin;
    float* out; unsigned char* ws;
};

template <int MODE>
__device__ __forceinline__ void transpose_item(const float* W, int K, int N, bf16* WT, const float* ga, const float* gb, LAS float* scr, int item, int lane) {
    const int nblk = N / 32, kb = item / nblk, nb = item % nblk, k0 = 64 * kb, n0 = 32 * nb;
#pragma unroll 8
    for (int i = 0; i < 32; ++i) { const int kk = 2 * i + (lane >> 5); float v = W[(size_t)(k0 + kk) * N + n0 + (lane & 31)];
        if (MODE == 3) { const int k = k0 + kk; v *= (k < 1024) ? ga[k] : gb[(k - 1024) & 127] * 0.8f; }
        scr[kk * 33 + (lane & 31)] = v; }
    asm volatile("s_waitcnt lgkmcnt(0)" ::: "memory");
    const int c = lane & 7;
#pragma unroll
    for (int j = 0; j < 4; ++j) { const int n = (lane >> 3) + 8 * j; const LAS float* s = scr + (8 * c) * 33 + n;
        v4u o; o.x = cvtpk(s[0 * 33], s[1 * 33]); o.y = cvtpk(s[2 * 33], s[3 * 33]); o.z = cvtpk(s[4 * 33], s[5 * 33]); o.w = cvtpk(s[6 * 33], s[7 * 33]);
        const int ng = n0 + n; int dr = ng;
        if (MODE == 1) dr = (ng >> 7) * 256 + (ng & 127);
        if (MODE == 2) dr = (ng >> 7) * 256 + 128 + (ng & 127);
        *(v4u*)(WT + (size_t)dr * K + k0 + 8 * c) = o; }
    asm volatile("s_waitcnt lgkmcnt(0)" ::: "memory");
}
__device__ __forceinline__ void ada_item(const float* c, const float* w_ada, float* mod, int item, int lane) {
    const int cch = item % 48, dch = item / 48, col0 = cch * 256 + 4 * lane, d0 = dch * 64;
    float sl[4];
#pragma unroll
    for (int b = 0; b < 4; ++b) { const float cv = c[b * DM + d0 + lane]; sl[b] = cv / (1.0f + __expf(-cv)); }
    f32x4 acc[4];
#pragma unroll
    for (int b = 0; b < 4; ++b) acc[b] = (f32x4){0.f, 0.f, 0.f, 0.f};
    for (int k8 = 0; k8 < 8; ++k8) {
#pragma unroll
        for (int j = 0; j < 8; ++j) { const int kk = k8 * 8 + j;
            const f32x4 w = *(const f32x4*)(w_ada + (size_t)(d0 + kk) * NMODC + col0);
#pragma unroll
            for (int b = 0; b < 4; ++b) { const float s = __uint_as_float(__builtin_amdgcn_readlane(__float_as_uint(sl[b]), kk)); acc[b] += w * s; } }
    }
#pragma unroll
    for (int b = 0; b < 4; ++b)
#pragma unroll
        for (int e = 0; e < 4; ++e) __hip_atomic_fetch_add(mod + (size_t)b * NMODC + col0 + e, acc[b][e], __ATOMIC_RELAXED, __HIP_MEMORY_SCOPE_AGENT);
}
__device__ __forceinline__ void norm_mod_phase(const float* X, bf16* H, const float* gain, const float* mod, const float* b_ada, int sh_off, int sc_off, int gw, int ngw, int lane) {
    for (int chunk = gw; chunk < MTOK / 16; chunk += ngw) {
        const int row0 = chunk * 16, b = row0 / SEQ;
        f32x4 A[8], Bv[8];
#pragma unroll
        for (int j = 0; j < 8; ++j) { const int col = 4 * lane + 256 * j;
            const f32x4 g = *(const f32x4*)(gain + col);
            const f32x4 sc = *(const f32x4*)(mod + (size_t)b * NMODC + sc_off + col) + *(const f32x4*)(b_ada + sc_off + col);
            Bv[j] = *(const f32x4*)(mod + (size_t)b * NMODC + sh_off + col) + *(const f32x4*)(b_ada + sh_off + col);
            A[j] = g * (sc + 1.0f); }
        for (int r = 0; r < 16; r += 2) {
            const f32x4* xr0 = (const f32x4*)(X + (size_t)(row0 + r) * DM) + lane;
            const f32x4* xr1 = xr0 + DM / 4;
            f32x4 v0[8], v1[8]; float s0 = 0.f, s1 = 0.f;
#pragma unroll
            for (int j = 0; j < 8; ++j) { v0[j] = xr0[64 * j]; v1[j] = xr1[64 * j]; }
#pragma unroll
            for (int j = 0; j < 8; ++j) { s0 += (v0[j].x * v0[j].x + v0[j].y * v0[j].y) + (v0[j].z * v0[j].z + v0[j].w * v0[j].w); s1 += (v1[j].x * v1[j].x + v1[j].y * v1[j].y) + (v1[j].z * v1[j].z + v1[j].w * v1[j].w); }
            const float rstd0 = 1.0f / sqrtf(wave_sum(s0) * (1.0f / DM) + EPS), rstd1 = 1.0f / sqrtf(wave_sum(s1) * (1.0f / DM) + EPS);
            v2u* o0 = (v2u*)(H + (size_t)(row0 + r) * DM) + lane; v2u* o1 = o0 + DM / 4;
#pragma unroll
            for (int j = 0; j < 8; ++j) { const f32x4 y0 = v0[j] * rstd0 * A[j] + Bv[j], y1 = v1[j] * rstd1 * A[j] + Bv[j];
                v2u w; w.x = cvtpk(y0.x, y0.y); w.y = cvtpk(y0.z, y0.w); o0[64 * j] = w; w.x = cvtpk(y1.x, y1.y); w.y = cvtpk(y1.z, y1.w); o1[64 * j] = w; }
        }
    }
}
__device__ __forceinline__ void final_norm_phase(float* X, const float* gain, int gw, int ngw, int lane) {
    f32x4 G[8];
#pragma unroll
    for (int j = 0; j < 8; ++j) G[j] = *(const f32x4*)(gain + 4 * lane + 256 * j);
    for (int row = gw; row < MTOK; row += 2 * ngw) {
        const int row1 = row + ngw; const bool has1 = row1 < MTOK;
        f32x4* xr0 = (f32x4*)(X + (size_t)row * DM) + lane; f32x4* xr1 = (f32x4*)(X + (size_t)(has1 ? row1 : row) * DM) + lane;
        f32x4 v0[8], v1[8]; float s0 = 0.f, s1 = 0.f;
#pragma unroll
        for (int j = 0; j < 8; ++j) { v0[j] = xr0[64 * j]; v1[j] = xr1[64 * j]; }
#pragma unroll
        for (int j = 0; j < 8; ++j) { s0 += (v0[j].x * v0[j].x + v0[j].y * v0[j].y) + (v0[j].z * v0[j].z + v0[j].w * v0[j].w); s1 += (v1[j].x * v1[j].x + v1[j].y * v1[j].y) + (v1[j].z * v1[j].z + v1[j].w * v1[j].w); }
        const float rstd0 = 1.0f / sqrtf(wave_sum(s0) * (1.0f / DM) + EPS), rstd1 = 1.0f / sqrtf(wave_sum(s1) * (1.0f / DM) + EPS);
#pragma unroll
        for (int j = 0; j < 8; ++j) xr0[64 * j] = v0[j] * rstd0 * G[j];
        if (has1) {
#pragma unroll
            for (int j = 0; j < 8; ++j) xr1[64 * j] = v1[j] * rstd1 * G[j]; }
    }
}
__device__ __forceinline__ void vt_item(const bf16* proj, bf16* VtA, unsigned char* KVB, LAS unsigned short* T, int item, int lane) {
    const int tb = item & 127, dh = (item >> 7) & 1, rest = item >> 8, vh = rest % 10, b = rest / 10;
    const int colbase = (vh < 2 ? O_VA + vh * 128 : O_VD + (vh - 2) * 128) + dh * 64, t0 = tb * 64;
#pragma unroll
    for (int i = 0; i < 8; ++i) { const int row = 8 * i + (lane >> 3), ch = lane & 7;
        const v4u v = *(const v4u*)(proj + (size_t)(b * SEQ + t0 + row) * INC + colbase + ch * 8);
        const unsigned w[4] = {v.x, v.y, v.z, v.w};
#pragma unroll
        for (int j = 0; j < 4; ++j) { T[(ch * 8 + 2 * j) * 66 + row] = (unsigned short)(w[j] & 0xffffu); T[(ch * 8 + 2 * j + 1) * 66 + row] = (unsigned short)(w[j] >> 16); } }
    asm volatile("s_waitcnt lgkmcnt(0)" ::: "memory");
#pragma unroll
    for (int i = 0; i < 8; ++i) { const int cc = 8 * i + (lane >> 3), q = lane & 7;
        const LAS unsigned* s = (const LAS unsigned*)(T + cc * 66 + q * 8);
        v4u o; o.x = s[0]; o.y = s[1]; o.z = s[2]; o.w = s[3];
        const int d = dh * 64 + cc;
        if (vh < 2) *(v4u*)(VtA + ((size_t)((b * 2 + vh) * 128 + d)) * SEQ + t0 + q * 8) = o;
        else *(v4u*)(KVB + ((size_t)((b * 8 + vh - 2) * 128 + tb)) * 32768 + 16384 + d * 128 + ((q ^ ((d >> 1) & 7)) << 4)) = o; }
    asm volatile("s_waitcnt lgkmcnt(0)" ::: "memory");
}

template <int DQK, int MODE>
__device__ __forceinline__ void attn_tile(const LAS unsigned char* Kt, const LAS unsigned char* Vtl, const bf16x8 (&qf)[DQK / 16], f32x16 (&O)[4], float& m, float& l,
                                          int qpos, int key0, float c1, float slope2, int lane) {
    constexpr int KROW = DQK * 2 + 16;
    const int r = lane & 31, hi = lane >> 5;
    const int kr = (r & 0x13) | ((r & 4) << 1) | ((r & 8) >> 1);
    f32x16 S0, S1;
#pragma unroll
    for (int t = 0; t < 16; ++t) { S0[t] = 0.f; S1[t] = 0.f; }
#pragma unroll
    for (int s = 0; s < DQK / 16; ++s) {
        const bf16x8 k0 = *(const LAS bf16x8*)(Kt + kr * KROW + s * 32 + hi * 16);
        const bf16x8 k1 = *(const LAS bf16x8*)(Kt + (32 + kr) * KROW + s * 32 + hi * 16);
        S0 = MFMA32(k0, qf[s], S0); S1 = MFMA32(k1, qf[s], S1);
    }
    float mx = -1e30f;
    const int dq = qpos - key0 - 8 * hi;
#pragma unroll
    for (int t = 0; t < 16; ++t) {
        const int d0 = dq - ((t & 7) + 16 * (t >> 3)), d1 = d0 - 32;
        const int a0 = d0 < 0 ? -d0 : d0, a1 = d1 < 0 ? -d1 : d1;
        float v0 = S0[t] - slope2 * (float)a0, v1 = S1[t] - slope2 * (float)a1;
        if (MODE == 1) { v0 = (a0 <= 128) ? v0 : -1e30f; v1 = (a1 <= 128) ? v1 : -1e30f; }
        S0[t] = v0; S1[t] = v1; mx = fmaxf(mx, fmaxf(v0, v1));
    }
    mx = fmaxf(mx, __shfl_xor(mx, 32));
    const float mnew = fmaxf(m, mx);
    if (__builtin_amdgcn_ballot_w64(mnew > m) != 0ull) {
        const float alpha = __builtin_amdgcn_exp2f(m - mnew);
        l *= alpha;
#pragma unroll
        for (int db = 0; db < 4; ++db) O[db] = O[db] * alpha;
    }
    m = mnew;
    float ps = 0.f;
#pragma unroll
    for (int t = 0; t < 16; ++t) { const float p0 = __builtin_amdgcn_exp2f(S0[t] - mnew), p1 = __builtin_amdgcn_exp2f(S1[t] - mnew); S0[t] = p0; S1[t] = p1; ps += p0 + p1; }
    l += ps;
    bf16x8 pf[4];
    { v4u w;
      w.x = cvtpk(S0[0], S0[1]); w.y = cvtpk(S0[2], S0[3]); w.z = cvtpk(S0[4], S0[5]); w.w = cvtpk(S0[6], S0[7]); pf[0] = __builtin_bit_cast(bf16x8, w);
      w.x = cvtpk(S0[8], S0[9]); w.y = cvtpk(S0[10], S0[11]); w.z = cvtpk(S0[12], S0[13]); w.w = cvtpk(S0[14], S0[15]); pf[1] = __builtin_bit_cast(bf16x8, w);
      w.x = cvtpk(S1[0], S1[1]); w.y = cvtpk(S1[2], S1[3]); w.z = cvtpk(S1[4], S1[5]); w.w = cvtpk(S1[6], S1[7]); pf[2] = __builtin_bit_cast(bf16x8, w);
      w.x = cvtpk(S1[8], S1[9]); w.y = cvtpk(S1[10], S1[11]); w.z = cvtpk(S1[12], S1[13]); w.w = cvtpk(S1[14], S1[15]); pf[3] = __builtin_bit_cast(bf16x8, w); }
#pragma unroll
    for (int db = 0; db < 4; ++db)
#pragma unroll
        for (int s4 = 0; s4 < 4; ++s4) {
            const bf16x8 vf = *(const LAS bf16x8*)(Vtl + (32 * db + r) * 144 + s4 * 32 + hi * 16);
            O[db] = MFMA32(vf, pf[s4], O[db]);
        }
}

__device__ __forceinline__ float xhalf_max(float x) { auto rr = __builtin_amdgcn_permlane32_swap(__float_as_uint(x), __float_as_uint(x), false, false); return fmaxf(__uint_as_float(rr[0]), __uint_as_float(rr[1])); }
__device__ __forceinline__ float xhalf_sum(float x) { auto rr = __builtin_amdgcn_permlane32_swap(__float_as_uint(x), __float_as_uint(x), false, false); return __uint_as_float(rr[0]) + __uint_as_float(rr[1]); }
constexpr int B_KB = 65536, B_VB = 0;
__device__ __forceinline__ void b_qk(const LAS unsigned char* Kt, const LAS unsigned char* Qw, const int (&kaddr)[4], const f32x16& ci, f32x16& S0, f32x16& S1) {
    bf16x8 kf[4], qf[4];
#pragma unroll
    for (int s = 0; s < 4; ++s) { kf[s] = *(const LAS bf16x8*)(Kt + kaddr[s]); qf[s] = *(const LAS bf16x8*)(Qw + s * 1024); }
    S0 = MFMA32(kf[0], qf[0], ci);
#pragma unroll
    for (int s = 1; s < 4; ++s) S0 = MFMA32(kf[s], qf[s], S0);
#pragma unroll
    for (int s = 0; s < 4; ++s) kf[s] = *(const LAS bf16x8*)(Kt + kaddr[s] + 4096);
    S1 = MFMA32(kf[0], qf[0], ci);
#pragma unroll
    for (int s = 1; s < 4; ++s) S1 = MFMA32(kf[s], qf[s], S1);
}
constexpr int B_QB = 131072;
#define B_WAITV(n) asm volatile("s_waitcnt vmcnt(" #n ")" ::: "memory")
#define B_BAR() do { asm volatile("s_waitcnt lgkmcnt(0)" ::: "memory"); __builtin_amdgcn_s_barrier(); asm volatile("" ::: "memory"); } while (0)
#define B_SCHED() __builtin_amdgcn_sched_barrier(0)
__device__ __forceinline__ void mfma_acc(f32x16& acc, const bf16x8& a, const bf16x8& b) { asm volatile("v_mfma_f32_32x32x16_bf16 %0, %1, %2, %0" : "+v"(acc) : "v"(a), "v"(b)); }
__device__ __forceinline__ void mfma_ini(f32x16& d, const bf16x8& a, const bf16x8& b, const f32x16& c) { asm volatile("v_mfma_f32_32x32x16_bf16 %0, %1, %2, %3" : "=&v"(d) : "v"(a), "v"(b), "v"(c)); }
__device__ __forceinline__ void exp_slice(float& p0, float& p1, float& ps, float a0, float a1, float m0, float m1) {
    asm volatile("v_sub_f32 %0, %3, %5\n\tv_sub_f32 %1, %4, %6\n\tv_exp_f32 %0, %0\n\tv_exp_f32 %1, %1\n\tv_add_f32 %2, %2, %0\n\tv_add_f32 %2, %2, %1" : "=&v"(p0), "=&v"(p1), "+v"(ps) : "v"(a0), "v"(a1), "v"(m0), "v"(m1)); }
template <int T4>
__device__ __forceinline__ void b_fstep(LAS unsigned char* lds, int t, int td, int c, int wave, const unsigned char* tile0, unsigned loff,
                                        const int (&kaddr)[4], const int (&vaddr)[4], const LAS unsigned char* Qw, f32x16& bvs, f32x16& A0, f32x16& A1, f32x16 (&O)[4], bf16x8 (&pp)[4],
                                        float& m, float& l, int qpos, int hi, float slope2) {
    constexpr int NT = SEQ / 64;
    { const int tk = (t + 3 < NT) ? t + 3 : NT - 1, tv = (t + 2 < NT) ? t + 2 : NT - 1;
      const unsigned char* kb = tile0 + (size_t)tk * 32768 + loff; const unsigned char* vb = tile0 + (size_t)tv * 32768 + 16384 + loff;
      __builtin_amdgcn_global_load_lds((const unsigned*)(kb), (LAS unsigned*)(lds + B_KB + ((T4 + 3) & 3) * 16384 + wave * 2048), 16, 0, 0);
      __builtin_amdgcn_global_load_lds((const unsigned*)(kb + 1024), (LAS unsigned*)(lds + B_KB + ((T4 + 3) & 3) * 16384 + wave * 2048 + 1024), 16, 0, 0);
      __builtin_amdgcn_global_load_lds((const unsigned*)(vb), (LAS unsigned*)(lds + B_VB + ((T4 + 2) & 3) * 16384 + wave * 2048), 16, 0, 0);
      __builtin_amdgcn_global_load_lds((const unsigned*)(vb + 1024), (LAS unsigned*)(lds + B_VB + ((T4 + 2) & 3) * 16384 + wave * 2048 + 1024), 16, 0, 0); }
    const int key0 = t * 64;
    float base, e1;
    if (t == td) {
        const int dq = qpos - key0 - 8 * hi;
#pragma unroll
        for (int r = 0; r < 16; ++r) { const int d0 = dq - ((r & 7) + 16 * (r >> 3)), d1 = d0 - 32;
            const int a0 = d0 < 0 ? -d0 : d0, a1 = d1 < 0 ? -d1 : d1;
            A0[r] = A0[r] - bvs[r] - slope2 * (float)a0; A1[r] = A1[r] - bvs[r] - slope2 * (float)a1; }
        bvs = -bvs; base = 0.f; e1 = 0.f;
    } else { const float sg = (t < td) ? slope2 : -slope2; base = sg * (float)(key0 + 8 * hi - qpos); e1 = sg * 32.0f; }
    B_SCHED();
    const LAS unsigned char* Vb = lds + B_VB + ((T4 + 3) & 3) * 16384;
    const LAS unsigned char* Kt = lds + ((T4 + 1) & 3) * 16384;
    f32x16 N0, N1;
    bf16x8 fa[4], fb[4], qf[4];
    float mx0 = -1e30f, mx1 = -1e30f, mnew = m, alpha = 1.0f, mr0 = 0.f, mr1 = 0.f, ps = 0.f;
    v4u w0, w1;
#pragma unroll
    for (int s4 = 0; s4 < 4; ++s4) fa[s4] = *(const LAS bf16x8*)(Vb + vaddr[s4]);
    B_SCHED();
#pragma unroll
    for (int i = 0; i < 24; ++i) {
        const int g = i >> 2, j = i & 3;
        if (j == 0) {
            if (g == 0) {
#pragma unroll
                for (int s4 = 0; s4 < 4; ++s4) fb[s4] = *(const LAS bf16x8*)(Vb + vaddr[s4] + 4096); }
            if (g == 1) {
#pragma unroll
                for (int s4 = 0; s4 < 4; ++s4) fa[s4] = *(const LAS bf16x8*)(Vb + vaddr[s4] + 8192); }
            if (g == 2) {
#pragma unroll
                for (int s4 = 0; s4 < 4; ++s4) fb[s4] = *(const LAS bf16x8*)(Vb + vaddr[s4] + 12288); }
            if (g == 3) {
#pragma unroll
                for (int s4 = 0; s4 < 4; ++s4) { fa[s4] = *(const LAS bf16x8*)(Kt + kaddr[s4]); qf[s4] = *(const LAS bf16x8*)(Qw + s4 * 1024); } }
            if (g == 4) {
#pragma unroll
                for (int s4 = 0; s4 < 4; ++s4) fb[s4] = *(const LAS bf16x8*)(Kt + kaddr[s4] + 4096); }
        }
        if (g == 0) mfma_acc(O[0], fa[j], pp[j]);
        if (g == 1) mfma_acc(O[1], fb[j], pp[j]);
        if (g == 2) mfma_acc(O[2], fa[j], pp[j]);
        if (g == 3) mfma_acc(O[3], fb[j], pp[j]);
        if (g == 4) { if (j == 0) N0 = MFMA32(fa[0], qf[0], bvs); else mfma_acc(N0, fa[j], qf[j]); }
        if (g == 5) { if (j == 0) N1 = MFMA32(fb[0], qf[0], bvs); else mfma_acc(N1, fb[j], qf[j]); }
        if (i < 4) {
#pragma unroll
            for (int r = 4 * i; r < 4 * i + 4; ++r) { mx0 = fmaxf(mx0, A0[r]); mx1 = fmaxf(mx1, A1[r]); } }
        if (i == 4) { const float mx = xhalf_max(fmaxf(mx0, mx1 + e1) + base); mnew = fmaxf(m, mx); alpha = __builtin_amdgcn_exp2f(m - mnew); mr0 = mnew - base; mr1 = mr0 - e1; }
        if (i >= 5 && i < 13) { const int r = 2 * (i - 5); float x0, x1; exp_slice(x0, x1, ps, A0[r], A0[r + 1], mr0, mr0); A0[r] = x0; A0[r + 1] = x1; }
        if (i == 13) { w0.x = cvtpk(A0[0], A0[1]); w0.y = cvtpk(A0[2], A0[3]); w0.z = cvtpk(A0[4], A0[5]); w0.w = cvtpk(A0[6], A0[7]);
                       w1.x = cvtpk(A0[8], A0[9]); w1.y = cvtpk(A0[10], A0[11]); w1.z = cvtpk(A0[12], A0[13]); w1.w = cvtpk(A0[14], A0[15]); }
        if (i >= 13 && i < 21) { const int r = 2 * (i - 13); float x0, x1; exp_slice(x0, x1, ps, A1[r], A1[r + 1], mr1, mr1); A1[r] = x0; A1[r + 1] = x1; }
        if (i == 21) { v4u w2, w3; w2.x = cvtpk(A1[0], A1[1]); w2.y = cvtpk(A1[2], A1[3]); w2.z = cvtpk(A1[4], A1[5]); w2.w = cvtpk(A1[6], A1[7]); pp[2] = __builtin_bit_cast(bf16x8, w2);
                       w3.x = cvtpk(A1[8], A1[9]); w3.y = cvtpk(A1[10], A1[11]); w3.z = cvtpk(A1[12], A1[13]); w3.w = cvtpk(A1[14], A1[15]); pp[3] = __builtin_bit_cast(bf16x8, w3); }
        if (i == 22) { pp[0] = __builtin_bit_cast(bf16x8, w0); pp[1] = __builtin_bit_cast(bf16x8, w1); }
        B_SCHED();
    }
    asm volatile("s_nop 15");
    if (__builtin_amdgcn_ballot_w64(mnew > m) != 0ull) {
#pragma unroll
        for (int db = 0; db < 4; ++db) O[db] = O[db] * alpha;
    }
    l = l * alpha + ps; m = mnew;
    A0 = N0; A1 = N1;
    B_WAITV(6); B_BAR();
}
__device__ __forceinline__ void attn_unit_B(LAS unsigned char* lds, const bf16* proj, const unsigned char* KVB, bf16* cat, int b, int h, int qb, float lam, int tid, int wave, int lane) {
    asm volatile("" : "+v"(lane));
    const int c = wave >> 2, sb = wave & 3, r = lane & 31, hi = lane >> 5;
    const int q0 = qb * 128 + sb * 32, qpos = q0 + r, td = q0 >> 6;
    const size_t rowbase = (size_t)b * SEQ;
    LAS unsigned char* Qw = lds + B_QB + wave * 4096 + lane * 16;
#pragma unroll
    for (int s = 0; s < 4; ++s) *(LAS bf16x8*)(Qw + s * 1024) = *(const bf16x8*)(proj + (rowbase + qpos) * INC + O_QD + h * 128 + c * 64 + 16 * s + 8 * hi);
    { const v4u z = {0u, 0u, 0u, 0u}; *(LAS v4u*)(lds + B_VB + 3 * 16384 + tid * 32) = z; *(LAS v4u*)(lds + B_VB + 3 * 16384 + tid * 32 + 16) = z; }
    f32x16 O[4];
#pragma unroll
    for (int db = 0; db < 4; ++db)
#pragma unroll
        for (int t = 0; t < 16; ++t) O[db][t] = 0.f;
    float m = -1e30f, l = 0.f;
    const float slope2 = __builtin_amdgcn_exp2f(-0.5f * (float)(9 + h)) * LOG2E;
    f32x16 bvs;
#pragma unroll
    for (int t = 0; t < 16; ++t) bvs[t] = slope2 * (float)((t & 7) + 16 * (t >> 3));
    const int kr = (r & 0x13) | ((r & 4) << 1) | ((r & 8) >> 1), kk = (kr >> 1) & 7, vk = (r >> 1) & 7;
    int kaddr[4], vaddr[4];
#pragma unroll
    for (int s = 0; s < 4; ++s) { kaddr[s] = B_KB + c * 8192 + kr * 128 + (((2 * s + hi) ^ kk) << 4); vaddr[s] = r * 128 + (((2 * s + hi) ^ vk) << 4); }
    const unsigned char* tile0 = KVB + ((size_t)((b * 8 + h) * 128)) * 32768;
    const unsigned loff = (unsigned)(wave * 2048 + lane * 16);
    const unsigned char* ks0 = tile0 + loff;
    const unsigned char* ks1 = ks0 + 1024;
    const unsigned char* vs0 = ks0 + 16384;
    const unsigned char* vs1 = vs0 + 1024;
#pragma unroll
    for (int i = 0; i < 3; ++i) {
        __builtin_amdgcn_global_load_lds((const unsigned*)(ks0 + i * 32768), (LAS unsigned*)(lds + B_KB + i * 16384 + wave * 2048), 16, 0, 0);
        __builtin_amdgcn_global_load_lds((const unsigned*)(ks1 + i * 32768), (LAS unsigned*)(lds + B_KB + i * 16384 + wave * 2048 + 1024), 16, 0, 0);
        if (i < 2) {
        __builtin_amdgcn_global_load_lds((const unsigned*)(vs0 + i * 32768), (LAS unsigned*)(lds + B_VB + i * 16384 + wave * 2048), 16, 0, 0);
        __builtin_amdgcn_global_load_lds((const unsigned*)(vs1 + i * 32768), (LAS unsigned*)(lds + B_VB + i * 16384 + wave * 2048 + 1024), 16, 0, 0); }
    }
    B_WAITV(0); B_BAR();
    f32x16 A0, A1;
    b_qk(lds, Qw, kaddr, bvs, A0, A1);
    B_BAR();
    bf16x8 pp[4];
#pragma unroll
    for (int s4 = 0; s4 < 4; ++s4) pp[s4] = (bf16x8){0, 0, 0, 0, 0, 0, 0, 0};
    for (int t = 0; t < SEQ / 64; t += 4) {
        b_fstep<0>(lds, t, td, c, wave, tile0, loff, kaddr, vaddr, Qw, bvs, A0, A1, O, pp, m, l, qpos, hi, slope2);
        b_fstep<1>(lds, t + 1, td, c, wave, tile0, loff, kaddr, vaddr, Qw, bvs, A0, A1, O, pp, m, l, qpos, hi, slope2);
        b_fstep<2>(lds, t + 2, td, c, wave, tile0, loff, kaddr, vaddr, Qw, bvs, A0, A1, O, pp, m, l, qpos, hi, slope2);
        b_fstep<3>(lds, t + 3, td, c, wave, tile0, loff, kaddr, vaddr, Qw, bvs, A0, A1, O, pp, m, l, qpos, hi, slope2);
    }
    {
        const LAS unsigned char* Vb = lds + B_VB + ((SEQ / 64 - 1) & 3) * 16384;
#pragma unroll
        for (int db = 0; db < 4; ++db) {
            bf16x8 vf[4];
#pragma unroll
            for (int s4 = 0; s4 < 4; ++s4) vf[s4] = *(const LAS bf16x8*)(Vb + vaddr[s4] + db * 4096);
#pragma unroll
            for (int s4 = 0; s4 < 4; ++s4) O[db] = MFMA32(vf[s4], pp[s4], O[db]);
        }
    }
    B_WAITV(0); B_BAR();
    l = xhalf_sum(l);
    const float inv = 1.0f / l;
    LAS float* X = (LAS float*)lds;
    if (c == 1) {
#pragma unroll
        for (int db = 0; db < 4; ++db)
#pragma unroll
            for (int t = 0; t < 16; ++t) X[(sb * 64 + db * 16 + t) * 64 + lane] = O[db][t] * inv;
    }
    __syncthreads();
    if (c == 0) {
        float ss = 0.f;
#pragma unroll
        for (int db = 0; db < 4; ++db)
#pragma unroll
            for (int t = 0; t < 16; ++t) { const float o = O[db][t] * inv - lam * X[(sb * 64 + db * 16 + t) * 64 + lane]; O[db][t] = o; ss += o * o; }
        ss = xhalf_sum(ss);
        const float rstd = 1.0f / sqrtf(ss * (1.0f / 128.0f) + EPS);
        bf16* orow = cat + (rowbase + qpos) * DM + 1024 + h * 128 + 4 * hi;
#pragma unroll
        for (int db = 0; db < 4; ++db)
#pragma unroll
            for (int g = 0; g < 4; ++g) { v2u w; w.x = cvtpk(O[db][4 * g] * rstd, O[db][4 * g + 1] * rstd); w.y = cvtpk(O[db][4 * g + 2] * rstd, O[db][4 * g + 3] * rstd);
                *(v2u*)(orow + 32 * db + 8 * g) = w; }
    }
    __syncthreads();
}

constexpr int A_KT = 64 * 272, A_VOFF = 2 * A_KT, A_SSQ = A_VOFF + 2 * 18432;
__device__ __forceinline__ void attn_unit_A(LAS unsigned char* lds, const bf16* proj, const bf16* VtAll, bf16* cat, const float* a_sink, int b, int n, int tid, int wave, int lane) {
    asm volatile("" : "+v"(lane), "+v"(tid));
    const int w = wave, g = w >> 2, r = lane & 31, hi = lane >> 5;
    const size_t rowbase = (size_t)b * SEQ;
    const float c1 = 0.08838834764831845f * LOG2E, slope2 = __builtin_amdgcn_exp2f(-0.5f * (float)(w + 1)) * LOG2E, sinkv = a_sink[w] * LOG2E;
    LAS float* ssq = (LAS float*)(lds + A_SSQ);
    for (int sbk = 0; sbk < 4; ++sbk) {
        const int p0 = n * 128 + sbk * 32, qpos = p0 + r;
        bf16x8 qf[8];
#pragma unroll
        for (int s = 0; s < 8; ++s) qf[s] = *(const bf16x8*)(proj + (rowbase + qpos) * INC + O_QA + w * 128 + 16 * s + 8 * hi);
        f32x16 O[4];
#pragma unroll
        for (int db = 0; db < 4; ++db)
#pragma unroll
            for (int t = 0; t < 16; ++t) O[db][t] = 0.f;
        float m = sinkv, l = (hi == 0) ? 1.0f : 0.0f;
        const int ts = ((p0 - 128) >> 6) << 6;
        for (int i = 0; i < 5; ++i) {
            const int key0 = ts + 64 * i;
            if (key0 < 0 || key0 >= SEQ) continue;
            __syncthreads();
#pragma unroll
            for (int j = 0; j < 4; ++j) { const int idx = tid + 512 * j, gk = idx >> 10, rem = idx & 1023;
                { const int row = rem >> 4, ch = rem & 15;
                  const v4u v = *(const v4u*)(proj + (rowbase + key0 + row) * INC + O_KA + gk * 128 + ch * 8);
                  *(LAS v4u*)(lds + gk * A_KT + row * 272 + ch * 16) = v; }
                { const int d = rem >> 3, ch = rem & 7;
                  const v4u v = *(const v4u*)(VtAll + ((size_t)((b * 2 + gk) * 128 + d)) * SEQ + key0 + ch * 8);
                  *(LAS v4u*)(lds + A_VOFF + gk * 18432 + d * 144 + ch * 16) = v; } }
            __syncthreads();
            attn_tile<128, 1>(lds + g * A_KT, lds + A_VOFF + g * 18432, qf, O, m, l, qpos, key0, c1, slope2, lane);
        }
        l += __shfl_xor(l, 32);
        const float inv = 1.0f / l;
        float ss = 0.f;
#pragma unroll
        for (int db = 0; db < 4; ++db)
#pragma unroll
            for (int t = 0; t < 16; ++t) { const float o = O[db][t] * inv; O[db][t] = o; ss += o * o; }
        ss += __shfl_xor(ss, 32);
        if (hi == 0) ssq[w * 128 + sbk * 32 + r] = ss;
        bf16* orow = cat + (rowbase + qpos) * DM + w * 128 + 4 * hi;
#pragma unroll
        for (int db = 0; db < 4; ++db)
#pragma unroll
            for (int gq = 0; gq < 4; ++gq) { v2u ww; ww.x = cvtpk(O[db][4 * gq], O[db][4 * gq + 1]); ww.y = cvtpk(O[db][4 * gq + 2], O[db][4 * gq + 3]);
                *(v2u*)(orow + 32 * db + 8 * gq) = ww; }
    }
    __syncthreads();
    for (int sbk = 0; sbk < 4; ++sbk) {
        const int ql = sbk * 32 + r;
        float tot = 0.f;
#pragma unroll
        for (int w2 = 0; w2 < 8; ++w2) tot += ssq[w2 * 128 + ql];
        const float rstd = 1.0f / sqrtf(tot * (1.0f / 1024.0f) + EPS);
        bf16* orow = cat + (rowbase + n * 128 + ql) * DM + w * 128 + 4 * hi;
#pragma unroll
        for (int db = 0; db < 4; ++db)
#pragma unroll
            for (int gq = 0; gq < 4; ++gq) { v2u* p = (v2u*)(orow + 32 * db + 8 * gq); const v2u ww = *p;
                v2u o; o.x = cvtpk(bf_lo(ww.x) * rstd, bf_hi(ww.x) * rstd); o.y = cvtpk(bf_lo(ww.y) * rstd, bf_hi(ww.y) * rstd); *p = o; }
    }
    __syncthreads();
}


#define XB_TMO      128
#define XB_XCNT(j)  (256  + 64 * (j))
#define XB_XSUB(j)  (1280 + 64 * (j))
#define XB_XGEN(j)  (2304 + 64 * (j))
#define XB_TOP      3328
#define XB_TOPGEN   3392
#define XCD_BAR_WORDS 3456
#define XB_SPIN_CAP (1u << 22)
__device__ __forceinline__ unsigned xb_ld(unsigned* p)              { return __hip_atomic_load(p, __ATOMIC_RELAXED, __HIP_MEMORY_SCOPE_AGENT); }
__device__ __forceinline__ unsigned xb_add(unsigned* p, unsigned v) { return __hip_atomic_fetch_add(p, v, __ATOMIC_RELAXED, __HIP_MEMORY_SCOPE_AGENT); }
__device__ __forceinline__ unsigned xb_xcc_id() { return (unsigned)__builtin_amdgcn_s_getreg((3 << 11) | 20) & 0xFu; }
#define XB_SPIN(cond, bar) do { unsigned _sp = 0; while (cond) { __builtin_amdgcn_s_sleep(1); \
    if ((++_sp & 255u) == 0u) { if (xb_ld(&(bar)[XB_TMO])) break; if (_sp > XB_SPIN_CAP) { atomicAdd(&(bar)[XB_TMO], 1u); break; } } } } while (0)
struct XcdBarrier { unsigned* bar; unsigned x, nloc, nx; };
__device__ __forceinline__ void xcd_barrier_complete(unsigned* bar, unsigned x, unsigned& nloc, unsigned& nx) {
    const unsigned G = gridDim.x;
    unsigned sum, cnt, mine, sp = 0u;
    for (;;) {
        sum = 0u; cnt = 0u; mine = 0u;
#pragma unroll
        for (unsigned j = 0; j < 16; ++j) { const unsigned c = xb_ld(&bar[XB_XCNT(j)]); sum += c; cnt += (c > 0u) ? 1u : 0u; mine = (j == x) ? c : mine; }
        if (sum == G) break;
        __builtin_amdgcn_s_sleep(1);
        if ((++sp & 255u) == 0u) { if (xb_ld(&bar[XB_TMO])) break; if (sp > XB_SPIN_CAP) { atomicAdd(&bar[XB_TMO], 1u); break; } }
    }
    nloc = mine > 0u ? mine : 1u; nx = cnt > 0u ? cnt : 1u;
}
__device__ __forceinline__ void xcd_barrier(const XcdBarrier& b) {
    asm volatile("s_waitcnt vmcnt(0)" ::: "memory");
    __syncthreads();
    if (threadIdx.x == 0) {
        unsigned* bar = b.bar;
        __builtin_amdgcn_s_waitcnt(0);
        const unsigned nloc = b.nloc, nx = b.nx;
        const unsigned old = xb_add(&bar[XB_XSUB(b.x)], 1u);
        const unsigned gen = old / nloc;
        if (old + 1u == (gen + 1u) * nloc) {
            __builtin_amdgcn_fence(__ATOMIC_RELEASE, "agent");
            asm volatile("s_waitcnt vmcnt(0)" ::: "memory");
            const unsigned og = xb_add(&bar[XB_TOP], 1u);
            const unsigned tg = og / nx;
            if (og + 1u == (tg + 1u) * nx) xb_add(&bar[XB_TOPGEN], 1u);
            else XB_SPIN(xb_ld(&bar[XB_TOPGEN]) == tg, bar);
            __builtin_amdgcn_fence(__ATOMIC_ACQUIRE, "agent");
            xb_add(&bar[XB_XGEN(b.x)], 1u);
            asm volatile("s_waitcnt vmcnt(0)" ::: "memory");
        } else {
            XB_SPIN(xb_ld(&bar[XB_XGEN(b.x)]) == gen, bar);
            __builtin_amdgcn_fence(__ATOMIC_ACQUIRE, "agent");
            asm volatile("s_waitcnt vmcnt(0)" ::: "memory");
        }
    }
    __syncthreads();
}

__global__ void __launch_bounds__(NTHR, 2) fwd_mega(Args a) {
    extern __shared__ __attribute__((aligned(16))) unsigned char lds_raw[];
    LAS unsigned char* lds = (LAS unsigned char*)lds_raw;
    cg::grid_group grid = cg::this_grid();
    int tid = threadIdx.x, lane = tid & 63; const int wave = __builtin_amdgcn_readfirstlane(tid >> 6);
#define FRESH_LANE() asm volatile("" : "+v"(lane), "+v"(tid))
    const int G = gridDim.x, bx = blockIdx.x;
    const int gw = bx * NWAVES + wave, ngw = G * NWAVES;
    unsigned char* ws = a.ws;
    XcdBarrier xb; xb.bar = (unsigned*)(ws + WS_BAR); xb.x = xb_xcc_id(); xb.nloc = 1u; xb.nx = 1u;
    if (tid == 0) (void)xb_add(&xb.bar[XB_XCNT(xb.x)], 1u);
    float* mod = (float*)(ws + WS_MOD);
    bf16* Win_t = (bf16*)(ws + WS_WIN); bf16* Wo_t = (bf16*)(ws + WS_WO); bf16* Wgu_t = (bf16*)(ws + WS_WGU); bf16* Wd_t = (bf16*)(ws + WS_WD);
    bf16* Hb = (bf16*)(ws + WS_H); bf16* cat = (bf16*)(ws + WS_CAT); bf16* proj = (bf16*)(ws + WS_PROJ); bf16* VtAll = (bf16*)(ws + WS_VT); unsigned char* KVB = ws + WS_KVB; bf16* FFb = (bf16*)(ws + WS_FF);

    FRESH_LANE();
    {
        for (int it = gw; it < 48 * 32; it += ngw) ada_item(a.c, a.w_ada, mod, it, lane);
        LAS float* scr = (LAS float*)(lds + wave * 16384);
        constexpr int I_IN = (DM / 64) * (INC / 32), I_O = (DM / 64) * (DM / 32), I_G = (DM / 64) * (DFF / 32), I_D = (DFF / 64) * (DM / 32);
        constexpr int NIT = I_IN + I_O + 2 * I_G + I_D;
        for (int it = gw; it < NIT; it += ngw) {
            int r = it;
            if (r < I_IN) { transpose_item<0>(a.w_in, DM, INC, Win_t, nullptr, nullptr, scr, r, lane); continue; } r -= I_IN;
            if (r < I_O) { transpose_item<3>(a.w_o, DM, DM, Wo_t, a.a_gain, a.subg, scr, r, lane); continue; } r -= I_O;
            if (r < I_G) { transpose_item<1>(a.w_gate, DM, DFF, Wgu_t, nullptr, nullptr, scr, r, lane); continue; } r -= I_G;
            if (r < I_G) { transpose_item<2>(a.w_up, DM, DFF, Wgu_t, nullptr, nullptr, scr, r, lane); continue; } r -= I_G;
            transpose_item<0>(a.w_down, DFF, DM, Wd_t, nullptr, nullptr, scr, r, lane);
        }
    }
    grid.sync();
    {
        volatile LAS unsigned* mb = (volatile LAS unsigned*)lds;
        if (tid == 0) { unsigned nloc, nx; xcd_barrier_complete(xb.bar, xb.x, nloc, nx); mb[0] = nloc; mb[1] = nx; }
        __syncthreads();
        xb.nloc = __builtin_amdgcn_readfirstlane(mb[0]); xb.nx = __builtin_amdgcn_readfirstlane(mb[1]);
        __syncthreads();
    }
    FRESH_LANE();
    norm_mod_phase(a.x, Hb, a.g1n, mod, a.b_ada, 0, DM, gw, ngw, lane);
    xcd_barrier(xb);
    {
        pg8::Gemm g{Hb, Win_t, MTOK, INC, DM}; pg8::StaticOrder S; S.init(MTOK, INC, G, bx);
        pg8::EpiStoreBf16 E{proj, INC, 0.08838834764831845f * LOG2E, 0.125f * LOG2E, KVB};
        pg8::gemm_phase<pg8::EpiStoreBf16, pg8::StaticOrder, true, true>(lds, g, S, E);
    }
    xcd_barrier(xb);
    FRESH_LANE();
    {
        LAS unsigned short* T = (LAS unsigned short*)(lds + wave * 8448);
        for (int it = gw; it < NB * 10 * 2 * 128; it += ngw) vt_item(proj, VtAll, KVB, T, it, lane);
    }
    xcd_barrier(xb);
    FRESH_LANE();
    {
        float s1 = 0.f, s2 = 0.f;
        for (int i = 0; i < 64; ++i) { s1 += a.lq1[i] * a.lk1[i]; s2 += a.lq2[i] * a.lk2[i]; }
        const float lam = __expf(s1) - __expf(s2) + 0.2f;
        for (int u = bx; u < NB * 64; u += G) attn_unit_A(lds, proj, VtAll, cat, a.a_sink, u >> 6, u & 63, tid, wave, lane);
        for (int v = bx; v < NB * 8 * 64; v += G) {
            const int xcd = v & 7, j = v >> 3, idx = j & 31, rnd = j >> 5;
            const int bh = xcd * 4 + (rnd >> 1), qb = (rnd & 1) * 32 + idx;
            attn_unit_B(lds, proj, KVB, cat, bh >> 3, bh & 7, qb, lam, tid, wave, lane);
        }
    }
    xcd_barrier(xb);
    {
        pg8::Gemm g{cat, Wo_t, MTOK, DM, DM}; pg8::StaticOrder S; S.init(MTOK, DM, G, bx);
        pg8::EpiResGate E{a.x, a.out, DM, mod + 2 * DM, a.b_ada + 2 * DM};
        pg8::gemm_phase<pg8::EpiResGate, pg8::StaticOrder, true, true>(lds, g, S, E);
    }
    xcd_barrier(xb);
    FRESH_LANE();
    norm_mod_phase(a.out, Hb, a.g2n, mod, a.b_ada, 3 * DM, 4 * DM, gw, ngw, lane);
    xcd_barrier(xb);
    {
        pg8::Gemm g{Hb, Wgu_t, MTOK, 2 * DFF, DM}; pg8::StaticOrder S; S.init(MTOK, 2 * DFF, G, bx);
        pg8::EpiSwiGLU E{FFb, DFF};
        pg8::gemm_phase<pg8::EpiSwiGLU, pg8::StaticOrder, true, true>(lds, g, S, E);
    }
    xcd_barrier(xb);
    {
        pg8::Gemm g{FFb, Wd_t, MTOK, DM, DFF}; pg8::StaticOrder S; S.init(MTOK, DM, G, bx);
        pg8::EpiResGate E{a.out, a.out, DM, mod + 5 * DM, a.b_ada + 5 * DM};
        pg8::gemm_phase<pg8::EpiResGate, pg8::StaticOrder, true, true>(lds, g, S, E);
    }
    xcd_barrier(xb);
    FRESH_LANE();
    final_norm_phase(a.out, a.gfin, gw, ngw, lane);
}

extern "C" void kernel_launch(void* const* d_in, const int* in_sizes, int n_in, void* d_out, int out_size, void* d_ws, size_t ws_size, hipStream_t stream) {
    static int grid = 0;
    if (grid == 0) {
        if (n_in != 19 || in_sizes[0] != MTOK * DM || out_size != MTOK * DM || ws_size < WS_END) {
            fprintf(stderr, "kernel_launch: unexpected shapes (n_in %d, in0 %d, out %d, ws %zu; need ws >= %zu)\n", n_in, n_in > 0 ? in_sizes[0] : -1, out_size, ws_size, (size_t)WS_END); grid = -1; return; }
        int dev = 0, cus = 0, per_cu = 0;
        if (hipGetDevice(&dev) != hipSuccess || hipDeviceGetAttribute(&cus, hipDeviceAttributeMultiprocessorCount, dev) != hipSuccess) { grid = -1; return; }
        if (hipFuncSetAttribute((const void*)fwd_mega, hipFuncAttributeMaxDynamicSharedMemorySize, LDS_BYTES) != hipSuccess) { fprintf(stderr, "kernel_launch: hipFuncSetAttribute failed\n"); grid = -1; return; }
        if (hipOccupancyMaxActiveBlocksPerMultiprocessor(&per_cu, (const void*)fwd_mega, NTHR, LDS_BYTES) != hipSuccess || per_cu < 1) { fprintf(stderr, "kernel_launch: occupancy query says %d\n", per_cu); per_cu = 1; }
        (void)hipGetLastError();
        grid = cus;
    }
    if (grid < 0) return;
    (void)hipMemsetAsync((char*)d_ws + WS_MOD, 0, WS_BAR + 16384, stream);
    Args a{};
    a.x = (const float*)d_in[0]; a.c = (const float*)d_in[1]; a.w_ada = (const float*)d_in[2]; a.b_ada = (const float*)d_in[3]; a.g1n = (const float*)d_in[4];
    a.w_in = (const float*)d_in[5]; a.a_sink = (const float*)d_in[6]; a.a_gain = (const float*)d_in[7]; a.lq1 = (const float*)d_in[8]; a.lk1 = (const float*)d_in[9];
    a.lq2 = (const float*)d_in[10]; a.lk2 = (const float*)d_in[11]; a.subg = (const float*)d_in[12]; a.w_o = (const float*)d_in[13]; a.g2n = (const float*)d_in[14];
    a.w_gate = (const float*)d_in[15]; a.w_up = (const float*)d_in[16]; a.w_down = (const float*)d_in[17]; a.gfin = (const float*)d_in[18];
    a.out = (float*)d_out; a.ws = (unsigned char*)d_ws;
    void* args[] = {&a};
    const hipError_t e = hipLaunchCooperativeKernel((const void*)fwd_mega, dim3(grid), dim3(NTHR), args, LDS_BYTES, stream);
    if (e != hipSuccess) fprintf(stderr, "kernel_launch: cooperative launch failed: %s (grid %d)\n", hipGetErrorString(e), grid);
}
```
